# Optimizing an MI355X kernel written in HIP

```python
import math
import jax, jax.numpy as jnp
from jax import lax
import numpy as np


D_MODEL = 1024
BATCH = 4
SEQ = 8192
DEPTH = 4

CHUNK = 64
Q_BLOCK = 128
EPS = 1e-6

D_MIX = D_MODEL
CONV_W = D_MIX // 4
CONV_K = 3
DIFF_HEADS = 4
DIFF_DH = D_MIX // 16
DIFF_DV = 2 * DIFF_DH
DIFF_W = DIFF_HEADS * DIFF_DV
GLA_HEADS = 4
GLA_DK = D_MIX // 16
GLA_DV = D_MIX // 16
GLA_W = GLA_HEADS * GLA_DV
GLA_RANK = 16
GLA_TAU = 16.0
D_FF = 4 * D_MODEL

SIZES = (CONV_W, CONV_W, CONV_W,
         DIFF_HEADS * 2 * DIFF_DH, DIFF_HEADS * 2 * DIFF_DH, DIFF_W,
         GLA_HEADS * GLA_DK, GLA_HEADS * GLA_DK, GLA_W, GLA_W, GLA_RANK)
D_IN = sum(SIZES)
SPLITS = tuple(int(s) for s in np.cumsum(SIZES)[:-1])

kernel_name = 'hybrid_conv_diffattn_gla_block'


def rms_norm(x, g):
    xf = x.astype(jnp.float32)
    y = xf * lax.rsqrt(jnp.mean(jnp.square(xf), axis=-1, keepdims=True) + EPS)
    return (y * g.astype(jnp.float32)).astype(x.dtype)


def short_conv(u, b_gate, c_gate, w):
    z = c_gate * u
    y = lax.conv_general_dilated(z, w.astype(z.dtype)[:, None, :], window_strides=(1,),
                                 padding=[(CONV_K - 1, 0)],
                                 dimension_numbers=('NWC', 'WIO', 'NWC'),
                                 feature_group_count=CONV_W)
    return b_gate * y


def diff_attention(q, k, v, q_g, k_g, lam, sub_g, lam_init):
    bsz, seq = q.shape[0], q.shape[1]
    q = rms_norm(q, q_g).astype(jnp.float32) * (DIFF_DH ** -0.5)
    k = rms_norm(k, k_g).astype(jnp.float32)
    v = v.astype(jnp.float32)
    nb = seq // Q_BLOCK
    qb = jnp.moveaxis(q.reshape(bsz, nb, Q_BLOCK, DIFF_HEADS, 2, DIFF_DH), 1, 0)
    pos = jnp.arange(seq)
    key_chunk = pos // CHUNK
    slopes = jnp.asarray([2.0 ** (-8.0 * (h + 1) / DIFF_HEADS) for h in range(DIFF_HEADS)],
                         dtype=jnp.float32)

    def block(args):
        q_blk, i = args
        tq = i * Q_BLOCK + jnp.arange(Q_BLOCK)
        dist = jnp.abs(tq[:, None] - pos[None, :]).astype(jnp.float32)
        visible = key_chunk[None, :] <= (tq // CHUNK)[:, None]
        bias = jnp.where(visible[None], -slopes[:, None, None] * dist[None], -jnp.inf)
        s = jnp.einsum('bqhcd,bkhcd->bchqk', q_blk, k) + bias
        p = jax.nn.softmax(s, axis=-1)
        a = p[:, 0] - lam * p[:, 1]
        return jnp.einsum('bhqk,bkhe->bqhe', a, v)

    o = lax.map(block, (qb, jnp.arange(nb)))
    o = jnp.moveaxis(o, 0, 1).reshape(bsz, seq, DIFF_HEADS, DIFF_DV)
    return rms_norm(o, sub_g) * (1.0 - lam_init)


def gla(q, k, v, g_out, a_lr, a_w, a_b, norm_g):
    bsz, seq = q.shape[0], q.shape[1]
    nc = seq // CHUNK
    shp_k = (bsz, nc, CHUNK, GLA_HEADS, GLA_DK)
    log_a = jax.nn.log_sigmoid((a_lr @ a_w + a_b).astype(jnp.float32)) / GLA_TAU
    b = jnp.cumsum(log_a.reshape(shp_k), axis=2)
    b_last = b[:, :, -1]
    qf = q.astype(jnp.float32).reshape(shp_k) * (GLA_DK ** -0.5)
    kf = k.astype(jnp.float32).reshape(shp_k)
    vf = v.astype(jnp.float32).reshape(bsz, nc, CHUNK, GLA_HEADS, GLA_DV)
    q_in = qf * jnp.exp(b)
    k_in = kf * jnp.exp(-b)
    k_end = kf * jnp.exp(b_last[:, :, None] - b)
    causal = jnp.tril(jnp.ones((CHUNK, CHUNK), dtype=bool))
    att = jnp.where(causal, jnp.einsum('bcthd,bcshd->bchts', q_in, k_in), 0.0)
    o_intra = jnp.einsum('bchts,bcshe->bcthe', att, vf)
    kv = jnp.einsum('bcshd,bcshe->bchde', k_end, vf)

    def step(state, inp):
        dec, kv_c = inp
        return dec[..., None] * state + kv_c, state

    s0 = jnp.zeros((bsz, GLA_HEADS, GLA_DK, GLA_DV), jnp.float32)
    _, s_prev = lax.scan(step, s0, (jnp.moveaxis(jnp.exp(b_last), 1, 0), jnp.moveaxis(kv, 1, 0)))
    o_inter = jnp.einsum('bcthd,bchde->bcthe', q_in, jnp.moveaxis(s_prev, 0, 1))
    o = (o_intra + o_inter).reshape(bsz, seq, GLA_HEADS, GLA_DV)
    o = rms_norm(o, norm_g).reshape(bsz, seq, GLA_W)
    return o * jax.nn.silu(g_out.astype(jnp.float32))


def setup_inputs(seed: int = 0) -> dict:
    key = jax.random.key(seed)
    ks = jax.random.split(key, 15)

    def nrm(k, shape, scale):
        return jax.random.normal(k, shape, jnp.float32) * scale

    return {
        'x': nrm(ks[0], (BATCH, SEQ, D_MODEL), 1.0),
        'ln1_g': 1.0 + nrm(ks[1], (DEPTH, D_MODEL), 0.02),
        'w_in': nrm(ks[2], (DEPTH, D_MODEL, D_IN), D_MODEL ** -0.5),
        'conv_w': nrm(ks[3], (DEPTH, CONV_K, CONV_W), CONV_K ** -0.5),
        'q_norm_g': 1.0 + nrm(ks[4], (DEPTH, DIFF_DH), 0.02),
        'k_norm_g': 1.0 + nrm(ks[5], (DEPTH, DIFF_DH), 0.02),
        'diff_lambda': nrm(ks[6], (DEPTH, 4, DIFF_DH), 0.1),
        'diff_subln_g': 1.0 + nrm(ks[7], (DEPTH, DIFF_DV), 0.02),
        'gla_alpha_w': nrm(ks[8], (DEPTH, GLA_RANK, GLA_HEADS * GLA_DK), GLA_RANK ** -0.5),
        'gla_alpha_b': nrm(ks[9], (DEPTH, GLA_HEADS * GLA_DK), 0.01),
        'gla_norm_g': 1.0 + nrm(ks[10], (DEPTH, GLA_DV), 0.02),
        'w_out': nrm(ks[11], (DEPTH, D_MIX, D_MODEL), D_MIX ** -0.5),
        'ln2_g': 1.0 + nrm(ks[12], (DEPTH, D_MODEL), 0.02),
        'w_mlp1': nrm(ks[13], (DEPTH, D_MODEL, D_FF), D_MODEL ** -0.5),
        'w_mlp2': nrm(ks[14], (DEPTH, D_FF, D_MODEL), D_FF ** -0.5),
    }


def reference(x, ln1_g, w_in, conv_w, q_norm_g, k_norm_g, diff_lambda, diff_subln_g,
              gla_alpha_w, gla_alpha_b, gla_norm_g, w_out, ln2_g, w_mlp1, w_mlp2):
    bsz, seq = x.shape[0], x.shape[1]
    for l in range(DEPTH):
        h = rms_norm(x, ln1_g[l])
        z = h @ w_in[l]
        (u, c_b, c_c, d_q, d_k, d_v, g_q, g_k, g_v, g_g, g_a) = jnp.split(z, SPLITS, axis=-1)
        y_conv = short_conv(u, c_b, c_c, conv_w[l])
        lam_init = 0.8 - 0.6 * math.exp(-0.3 * l)
        lp = diff_lambda[l].astype(jnp.float32)
        lam = jnp.exp(jnp.sum(lp[0] * lp[1])) - jnp.exp(jnp.sum(lp[2] * lp[3])) + lam_init
        y_diff = diff_attention(d_q.reshape(bsz, seq, DIFF_HEADS, 2, DIFF_DH),
                                d_k.reshape(bsz, seq, DIFF_HEADS, 2, DIFF_DH),
                                d_v.reshape(bsz, seq, DIFF_HEADS, DIFF_DV),
                                q_norm_g[l], k_norm_g[l], lam, diff_subln_g[l], lam_init)
        y_gla = gla(g_q, g_k, g_v, g_g, g_a, gla_alpha_w[l], gla_alpha_b[l], gla_norm_g[l])
        y = jnp.concatenate([y_conv.astype(x.dtype),
                             y_diff.reshape(bsz, seq, DIFF_W).astype(x.dtype),
                             y_gla.astype(x.dtype)], axis=-1)
        x = x + y @ w_out[l]
        h2 = rms_norm(x, ln2_g[l])
        x = x + jnp.square(jax.nn.relu(h2 @ w_mlp1[l])) @ w_mlp2[l]
    return x
```

```cpp
#include <hip/hip_runtime.h>
#include <hip/hip_cooperative_groups.h>
#include <cstdio>
#include <cstdint>
namespace cg = cooperative_groups;
namespace pg8 {
#define PG8_LAS __attribute__((address_space(3)))
typedef unsigned short bf16_t;
typedef short bf16x8 __attribute__((ext_vector_type(8)));
typedef float f32x4 __attribute__((ext_vector_type(4)));
typedef unsigned u32x4 __attribute__((ext_vector_type(4)));
constexpr int BM = 256, BK = 64, HALF = 128, HTB = HALF * BK * 2  , STAGE_BYTES = 8 * HTB, NXCD = 8, WGM = 8;

__host__ __device__ __forceinline__ int lds_byte(int r, int c) { const int st = (r >> 4) * 2 + (c >> 5), rr = r & 15, cc = c & 31, ob = rr * 64 + cc * 2; return st * 1024 + (ob ^ (((ob >> 9) & 1) << 5)); }
__host__ __device__ __forceinline__ void stage_rc(int b, int& R, int& C) { const int st = b / 1024, sb = b % 1024, swz = sb ^ (((sb >> 9) & 1) << 5); R = (st >> 1) * 16 + swz / 64; C = (st & 1) * 32 + (swz % 64) / 2; }
__host__ __device__ __forceinline__ int perm32(int rho) { const int n = rho >> 4, i = rho & 15; return 8 * (i >> 2) + 4 * n + (i & 3); }

struct Unit { int pm, pn; };
struct Gemm { const bf16_t* A; const bf16_t* Bt; int M, N, K; };

struct StaticOrder {
    int nM, nN, nwg, G, c;
    __host__ __device__ void init(int M, int N, int G_, int c_) { nM = M / BM; nN = N / BM; nwg = nM * nN; G = G_; c = c_; }
    __host__ __device__ bool next(int i, Unit& u) const {
        const long L = (long)i * G + c; if (L >= nwg) return false;
        int wgid = (int)L; { const int q = nwg / NXCD, r = nwg % NXCD, xcd = wgid % NXCD, off = wgid / NXCD; wgid = (xcd < r ? xcd * (q + 1) : r * (q + 1) + (xcd - r) * q) + off; }
        const int nig = WGM * nN, gid = wgid / nig, fm = gid * WGM, gsz = (nM - fm) < WGM ? (nM - fm) : WGM;
        u.pm = fm + ((wgid % nig) % gsz); u.pn = (wgid % nig) / gsz; return true;
    }
    __device__ __forceinline__ void a_ready(const Unit&) const {}
    __device__ __forceinline__ void done(const Unit&) const {}
};
__device__ __forceinline__ unsigned cvt_pk_bf16(float lo, float hi) { unsigned r; asm volatile("v_cvt_pk_bf16_f32 %0, %1, %2" : "=v"(r) : "v"(lo), "v"(hi)); return r; }
typedef float f32x2 __attribute__((ext_vector_type(2)));
template <class Epi, class Sched, bool ALIGN_EPI = false, bool SP2 = false>
__device__ __forceinline__ void gemm_phase(PG8_LAS unsigned char* lds, const Gemm g, const Sched& S, const Epi& E) {
    int tid = threadIdx.x; asm volatile("" : "+v"(tid));
    const int wid = __builtin_amdgcn_readfirstlane(tid >> 6), lane = tid & 63, wr = wid >> 2, wc = wid & 3, fr = lane & 15, fq = lane >> 4;
    const int K = g.K, nt = K / BK;
    unsigned voffA[2], voffB[2];
#pragma unroll
    for (int i = 0; i < 2; ++i) { int R, C; stage_rc(tid * 16 + i * 8192, R, C); const int Rb = Epi::PERM ? ((R & ~31) + perm32(R & 31)) : R;
        voffA[i] = (unsigned)(R * K + C) * 2u; voffB[i] = (unsigned)(Rb * K + C) * 2u; }
    const size_t kstep = (size_t)(BK * 2);
    const size_t hstep = (size_t)HALF * K * 2;
    const size_t tstep = 2 * hstep;
    const unsigned ldsw = (unsigned)wid * 1024u;
    const int aoff = lds_byte(wr * 64 + fr, fq * 8), boff = lds_byte(wc * 32 + fr, fq * 8);
#define PG8_SA(b, h) (((b) * 2 + (h)) * HTB)
#define PG8_SB(b, h) ((4 + (b) * 2 + (h)) * HTB)
#define PG8_STAGE(bufoff, gbase, voff) do { _Pragma("unroll") for (int _i = 0; _i < 2; ++_i) \
        __builtin_amdgcn_global_load_lds((const unsigned*)((const char*)(gbase) + (voff)[_i]), (PG8_LAS unsigned*)(lds + (bufoff) + ldsw + _i * 8192), 16, 0, 0); } while (0)
#define PG8_LDA(dst, b, h) do { _Pragma("unroll") for (int m = 0; m < 4; ++m) _Pragma("unroll") for (int k = 0; k < 2; ++k) dst[m][k] = *(const PG8_LAS bf16x8*)(lds + PG8_SA(b, h) + aoff + m * 2048 + k * 1024); } while (0)
#define PG8_LDB(dst, b, h) do { _Pragma("unroll") for (int n = 0; n < 2; ++n) _Pragma("unroll") for (int k = 0; k < 2; ++k) dst[n][k] = *(const PG8_LAS bf16x8*)(lds + PG8_SB(b, h) + boff + n * 2048 + k * 1024); } while (0)
#define PG8_MMA(ai, bj, At, Bt) do { __builtin_amdgcn_s_setprio(1); _Pragma("unroll") for (int m = 0; m < 4; ++m) _Pragma("unroll") for (int n = 0; n < 2; ++n) _Pragma("unroll") for (int k = 0; k < 2; ++k) \
        acc[ai][bj][m][n] = __builtin_amdgcn_mfma_f32_16x16x32_bf16(Bt[n][k], At[m][k], acc[ai][bj][m][n], 0, 0, 0); __builtin_amdgcn_s_setprio(0); } while (0)
#define PG8_WAIT_V(n) asm volatile("s_waitcnt vmcnt(" #n ")" ::: "memory")
#define PG8_WAIT_L(n) asm volatile("s_waitcnt lgkmcnt(" #n ")" ::: "memory")
#define PG8_BAR __builtin_amdgcn_s_barrier()
#define PG8_SCHED __builtin_amdgcn_sched_barrier(0)
    Unit cur, nxt; int ui = 0;
    if (!S.next(0, cur)) return;
    f32x4 acc[2][2][4][2];
#pragma unroll
    for (int a = 0; a < 2; ++a)
#pragma unroll
        for (int b = 0; b < 2; ++b)
#pragma unroll
            for (int m = 0; m < 4; ++m)
#pragma unroll
                for (int n = 0; n < 2; ++n) acc[a][b][m][n] = (f32x4){0.f, 0.f, 0.f, 0.f};
    bf16x8 At[4][2], B0[2][2], B1[2][2];
    const char* cA = (const char*)g.A + (size_t)cur.pm * tstep; const char* cB = (const char*)g.Bt + (size_t)cur.pn * tstep;
    S.a_ready(cur);
    if constexpr (SP2) {
        PG8_STAGE(PG8_SB(0, 0), cB, voffB); PG8_STAGE(PG8_SB(0, 1), cB + hstep, voffB); PG8_STAGE(PG8_SA(0, 0), cA, voffA); PG8_STAGE(PG8_SA(0, 1), cA + hstep, voffA);
        if (wr == 1) PG8_BAR;
        PG8_WAIT_V(2); PG8_BAR;
        PG8_STAGE(PG8_SB(1, 0), cB + kstep, voffB); PG8_STAGE(PG8_SA(1, 0), cA + kstep, voffA); PG8_STAGE(PG8_SB(1, 1), cB + hstep + kstep, voffB);
        PG8_WAIT_V(6); PG8_BAR;
    } else {
        PG8_STAGE(PG8_SB(0, 0), cB, voffB); PG8_STAGE(PG8_SA(0, 0), cA, voffA); PG8_STAGE(PG8_SB(0, 1), cB + hstep, voffB); PG8_STAGE(PG8_SA(0, 1), cA + hstep, voffA);
        if (wr == 1) PG8_BAR;
        PG8_WAIT_V(4); PG8_BAR;
        PG8_STAGE(PG8_SB(1, 0), cB + kstep, voffB); PG8_STAGE(PG8_SA(1, 0), cA + kstep, voffA); PG8_STAGE(PG8_SB(1, 1), cB + hstep + kstep, voffB);
        PG8_WAIT_V(6); PG8_BAR;
    }
    for (;;) {
        const bool has_next = S.next(ui + 1, nxt);
        const char* nA = has_next ? (const char*)g.A + (size_t)nxt.pm * tstep : cA; const char* nB = has_next ? (const char*)g.Bt + (size_t)nxt.pn * tstep : cB;
        for (int t = 0; t < nt; t += 2) {
            const bool last = (t == nt - 2);
            const char* a1 = cA + (size_t)(t + 1) * kstep;
            const char* a2 = last ? nA : cA + (size_t)(t + 2) * kstep; const char* b2 = last ? nB : cB + (size_t)(t + 2) * kstep;
            const char* a3 = a2 + kstep; const char* b3 = b2 + kstep;
            if (last && has_next) S.a_ready(nxt);
            if constexpr (SP2) {
            PG8_LDB(B0, 0, 0); PG8_LDB(B1, 0, 1); PG8_SCHED; PG8_LDA(At, 0, 0); PG8_STAGE(PG8_SA(1, 1), a1 + hstep, voffA);
            PG8_WAIT_V(8); PG8_WAIT_L(0); PG8_BAR; PG8_MMA(0, 0, At, B0); PG8_MMA(0, 1, At, B1); PG8_BAR; PG8_SCHED;
            PG8_LDA(At, 0, 1); PG8_STAGE(PG8_SB(0, 0), b2, voffB); PG8_STAGE(PG8_SB(0, 1), b2 + hstep, voffB); PG8_STAGE(PG8_SA(0, 0), a2, voffA);
            PG8_WAIT_V(8); PG8_WAIT_L(0); PG8_BAR; PG8_MMA(1, 0, At, B0); PG8_MMA(1, 1, At, B1); PG8_BAR; PG8_SCHED;
            PG8_LDB(B0, 1, 0); PG8_LDB(B1, 1, 1); PG8_SCHED; PG8_LDA(At, 1, 0); PG8_STAGE(PG8_SA(0, 1), a2 + hstep, voffA);
            PG8_WAIT_V(8); PG8_WAIT_L(0); PG8_BAR; PG8_MMA(0, 0, At, B0); PG8_MMA(0, 1, At, B1); PG8_BAR; PG8_SCHED;
            PG8_LDA(At, 1, 1); PG8_STAGE(PG8_SB(1, 0), b3, voffB); PG8_STAGE(PG8_SB(1, 1), b3 + hstep, voffB); PG8_STAGE(PG8_SA(1, 0), a3, voffA);
            PG8_WAIT_V(8); PG8_WAIT_L(0); PG8_BAR; PG8_MMA(1, 0, At, B0); PG8_MMA(1, 1, At, B1); PG8_BAR; PG8_SCHED;
            } else {
            PG8_LDB(B0, 0, 0); PG8_SCHED; PG8_LDA(At, 0, 0); PG8_STAGE(PG8_SA(1, 1), a1 + hstep, voffA);
            PG8_WAIT_L(8); PG8_BAR; PG8_WAIT_L(0); PG8_MMA(0, 0, At, B0); PG8_BAR; PG8_SCHED;
            PG8_LDB(B1, 0, 1); PG8_STAGE(PG8_SB(0, 0), b2, voffB);
            PG8_BAR; PG8_WAIT_L(0); PG8_MMA(0, 1, At, B1); PG8_BAR;
            PG8_LDA(At, 0, 1); PG8_STAGE(PG8_SA(0, 0), a2, voffA);
            PG8_BAR; PG8_WAIT_L(0); PG8_MMA(1, 0, At, B0); PG8_BAR; PG8_SCHED;
            PG8_STAGE(PG8_SB(0, 1), b2 + hstep, voffB);
            PG8_WAIT_V(6); PG8_BAR; PG8_MMA(1, 1, At, B1); PG8_BAR;
            PG8_LDB(B0, 1, 0); PG8_SCHED; PG8_LDA(At, 1, 0); PG8_STAGE(PG8_SA(0, 1), a2 + hstep, voffA);
            PG8_WAIT_L(8); PG8_BAR; PG8_WAIT_L(0); PG8_MMA(0, 0, At, B0); PG8_BAR; PG8_SCHED;
            PG8_LDB(B1, 1, 1); PG8_STAGE(PG8_SB(1, 0), b3, voffB);
            PG8_BAR; PG8_WAIT_L(0); PG8_MMA(0, 1, At, B1); PG8_BAR;
            PG8_LDA(At, 1, 1); PG8_STAGE(PG8_SA(1, 0), a3, voffA);
            PG8_BAR; PG8_WAIT_L(0); PG8_MMA(1, 0, At, B0); PG8_BAR; PG8_SCHED;
            PG8_STAGE(PG8_SB(1, 1), b3 + hstep, voffB);
            PG8_WAIT_V(6); PG8_BAR; PG8_MMA(1, 1, At, B1); PG8_BAR;
            }
        }
        if constexpr (ALIGN_EPI) { if (wr == 0) PG8_BAR; }
        if constexpr (!Epi::AFTER_DRAIN) { E(acc, cur, wr, wc, fr, fq); S.done(cur); }
        if (!has_next) break;
#pragma unroll
        for (int a = 0; a < 2; ++a)
#pragma unroll
            for (int b = 0; b < 2; ++b)
#pragma unroll
                for (int m = 0; m < 4; ++m)
#pragma unroll
                    for (int n = 0; n < 2; ++n) acc[a][b][m][n] = (f32x4){0.f, 0.f, 0.f, 0.f};
        cur = nxt; cA = nA; cB = nB; ++ui;
        if constexpr (ALIGN_EPI) { if (wr == 1) PG8_BAR; }
    }
    PG8_WAIT_V(0);
    if constexpr (!ALIGN_EPI) { if (wr == 0) PG8_BAR; }
    PG8_BAR;
    if constexpr (Epi::AFTER_DRAIN) { E.fused(acc, cur, wr, wc, fr, fq, lds, wid, lane); S.done(cur); }
#undef PG8_SA
#undef PG8_SB
#undef PG8_STAGE
#undef PG8_LDA
#undef PG8_LDB
#undef PG8_MMA
#undef PG8_WAIT_V
#undef PG8_WAIT_L
#undef PG8_BAR
#undef PG8_SCHED
}
}
#define LAS __attribute__((address_space(3)))

#define XB_TMO      128
#define XB_XCNT(j)  (256  + 64 * (j))
#define XB_XSUB(j)  (1280 + 64 * (j))
#define XB_XGEN(j)  (2304 + 64 * (j))
#define XB_TOP      3328
#define XB_TOPGEN   3392
#define XCD_BAR_WORDS 3456
#define XB_SPIN_CAP (1u << 18)

__device__ __forceinline__ unsigned xb_ld(unsigned* p)              { return __hip_atomic_load(p, __ATOMIC_RELAXED, __HIP_MEMORY_SCOPE_AGENT); }
__device__ __forceinline__ unsigned xb_add(unsigned* p, unsigned v) { return __hip_atomic_fetch_add(p, v, __ATOMIC_RELAXED, __HIP_MEMORY_SCOPE_AGENT); }
__device__ __forceinline__ unsigned xb_xcc_id() { return (unsigned)__builtin_amdgcn_s_getreg((3 << 11) | 20) & 0xFu; }
#define XB_SPIN(cond, bar) do { unsigned _sp = 0; while (cond) { __builtin_amdgcn_s_sleep(1); \
    if ((++_sp & 255u) == 0u) { if (xb_ld(&(bar)[XB_TMO])) break; if (_sp > XB_SPIN_CAP) { atomicAdd(&(bar)[XB_TMO], 1u); break; } } } } while (0)

struct XcdBarrier {
    unsigned* bar; unsigned x;
    volatile LAS unsigned* st;
};

__device__ __forceinline__ XcdBarrier xcd_barrier_post(unsigned* bar, volatile LAS unsigned* st) {
    XcdBarrier b; b.bar = bar; b.x = xb_xcc_id(); b.st = st;
    if (threadIdx.x == 0) (void)xb_add(&bar[XB_XCNT(b.x)], 1u);
    return b;
}
__device__ __forceinline__ void xcd_barrier_complete(unsigned* bar, unsigned x, unsigned& nloc, unsigned& nx) {
    const unsigned G = gridDim.x * gridDim.y * gridDim.z;
    unsigned sum, cnt, mine, sp = 0u;
    for (;;) {
        sum = 0u; cnt = 0u; mine = 0u;
#pragma unroll
        for (unsigned j = 0; j < 16; ++j) { const unsigned c = xb_ld(&bar[XB_XCNT(j)]); sum += c; cnt += (c > 0u) ? 1u : 0u; mine = (j == x) ? c : mine; }
        if (sum == G) break;
        __builtin_amdgcn_s_sleep(1);
        if ((++sp & 255u) == 0u) { if (xb_ld(&bar[XB_TMO])) break; if (sp > XB_SPIN_CAP) { atomicAdd(&bar[XB_TMO], 1u); break; } }
    }
    nloc = mine > 0u ? mine : 1u; nx = cnt > 0u ? cnt : 1u;
}

__device__ __forceinline__ void xcd_barrier(const XcdBarrier& b) {
    asm volatile("s_waitcnt vmcnt(0)" ::: "memory");
    __syncthreads();
    if (threadIdx.x == 0) {
        unsigned* bar = b.bar;
        __builtin_amdgcn_s_waitcnt(0);
        unsigned nloc = b.st[0], nx = b.st[1];
        if (nloc == 0u) { xcd_barrier_complete(bar, b.x, nloc, nx); b.st[0] = nloc; b.st[1] = nx; }
        const unsigned old = xb_add(&bar[XB_XSUB(b.x)], 1u);
        const unsigned gen = old / nloc;
        if (old + 1u == (gen + 1u) * nloc) {
            __builtin_amdgcn_fence(__ATOMIC_RELEASE, "agent");
            asm volatile("s_waitcnt vmcnt(0)" ::: "memory");
            const unsigned og = xb_add(&bar[XB_TOP], 1u);
            const unsigned tg = og / nx;
            if (og + 1u == (tg + 1u) * nx) xb_add(&bar[XB_TOPGEN], 1u);
            else XB_SPIN(xb_ld(&bar[XB_TOPGEN]) == tg, bar);
            __builtin_amdgcn_fence(__ATOMIC_ACQUIRE, "agent");
            xb_add(&bar[XB_XGEN(b.x)], 1u);
            asm volatile("s_waitcnt vmcnt(0)" ::: "memory");
        } else {
            XB_SPIN(xb_ld(&bar[XB_XGEN(b.x)]) == gen, bar);
            __builtin_amdgcn_fence(__ATOMIC_ACQUIRE, "agent");
            asm volatile("s_waitcnt vmcnt(0)" ::: "memory");
        }
    }
    __syncthreads();
}


#define DI __device__ __forceinline__
#define LAS __attribute__((address_space(3)))
typedef unsigned short bf16_t;
typedef short bf16x8 __attribute__((ext_vector_type(8)));
typedef short s16x4 __attribute__((ext_vector_type(4)));
typedef float f32x4 __attribute__((ext_vector_type(4)));
typedef float f32x16 __attribute__((ext_vector_type(16)));
typedef unsigned u32x4 __attribute__((ext_vector_type(4)));
typedef unsigned u32x2 __attribute__((ext_vector_type(2)));
typedef LAS unsigned char* ldsp;

constexpr int D = 1024, NB = 4, SEQ = 8192, DEPTH = 4, M = NB * SEQ;
constexpr int DIN = 3344, ZLD = 3584, FF = 4096;
constexpr int C_U = 0, C_CB = 256, C_CC = 512, C_DQ = 768, C_DK = 1280, C_DV = 1792, C_GQ = 2304, C_GK = 2560, C_GV = 2816, C_GG = 3072, C_GA = 3328;
constexpr float EPS = 1e-6f;
constexpr float LOG2E = 1.4426950408889634f;

constexpr size_t LW_IN = (size_t)ZLD * D * 2, LW_OUT = (size_t)D * D * 2, LW_1 = (size_t)FF * D * 2, LW_2 = (size_t)D * FF * 2;
constexpr size_t LW = LW_IN + LW_OUT + LW_1 + LW_2;
constexpr size_t WS_WT = 0;
constexpr size_t WS_XB = WS_WT + DEPTH * LW;
constexpr size_t WS_VT = WS_XB;
constexpr size_t WS_ST = WS_XB + (size_t)32 * 1024 * 1024;
constexpr size_t WS_Z = WS_XB + (size_t)M * D * 2;
constexpr size_t WS_Y = WS_Z + (size_t)M * ZLD * 2;
constexpr size_t WS_SSQ1 = WS_Y + (size_t)M * D * 2;
constexpr size_t WS_SSQ2 = WS_SSQ1 + (size_t)M * 16 * 4;
constexpr size_t WS_DEC = WS_SSQ2 + (size_t)M * 16 * 4;
constexpr size_t WS_CTR = WS_DEC + (size_t)16 * 128 * 64 * 4;
constexpr size_t WS_BAR = WS_CTR + 16384;
constexpr size_t WS_END = WS_BAR + 16384;
static_assert(WS_Z + (size_t)M * FF * 2 <= WS_SSQ1, "h overlays z and y only");
static_assert(WS_END <= (size_t)512 * 1024 * 1024, "workspace");
constexpr int LDS_PHASE = 131072, LDS_BYTES = LDS_PHASE + 64;
DI float bflo(unsigned v) { return __uint_as_float(v << 16); }
DI float bfhi(unsigned v) { return __uint_as_float(v & 0xffff0000u); }
DI float bf1(bf16_t v) { return __uint_as_float((unsigned)v << 16); }
DI unsigned pk(float lo, float hi) { return pg8::cvt_pk_bf16(lo, hi); }
DI bf16_t f2bf(float f) { return (bf16_t)(pk(f, 0.f) & 0xffffu); }
#define LDS_WAIT() asm volatile("s_waitcnt lgkmcnt(0)" ::: "memory")

struct EpiScale {
    static constexpr bool PERM = true, AFTER_DRAIN = false;
    bf16_t* O; int ldc; const float* ssq; int act;
    DI void operator()(const f32x4 (&acc)[2][2][4][2], const pg8::Unit& u, int wr, int wc, int fr, int fq) const {
        const int row0 = u.pm * 256 + wr * 64 + fr, col0 = u.pn * 256 + wc * 32 + 8 * fq;
        f32x4 pp[8];
#pragma unroll
        for (int g = 0; g < 8; ++g) pp[g] = *(const f32x4*)(ssq + (size_t)(row0 + (g >> 2) * 128 + (g & 3) * 16) * 16 + 4 * fq);
#pragma unroll
        for (int ai = 0; ai < 2; ++ai)
#pragma unroll
            for (int m = 0; m < 4; ++m) {
                const int row = row0 + ai * 128 + m * 16;
                const f32x4 p = pp[ai * 4 + m];
                float s = (p[0] + p[1]) + (p[2] + p[3]);
                s += __shfl_xor(s, 16); s += __shfl_xor(s, 32);
                const float rstd = rsqrtf(s * (1.0f / D) + EPS);
                bf16_t* rowp = O + (size_t)row * ldc + col0;
#pragma unroll
                for (int bj = 0; bj < 2; ++bj) {
                    f32x4 v0 = acc[ai][bj][m][0] * rstd, v1 = acc[ai][bj][m][1] * rstd;
                    if (act) {
#pragma unroll
                        for (int k = 0; k < 4; ++k) { float a = fmaxf(v0[k], 0.f), b = fmaxf(v1[k], 0.f); v0[k] = a * a; v1[k] = b * b; }
                    }
                    u32x4 w; w.x = pk(v0[0], v0[1]); w.y = pk(v0[2], v0[3]); w.z = pk(v1[0], v1[1]); w.w = pk(v1[2], v1[3]);
                    *(u32x4*)(rowp + bj * 128) = w;
                }
            }
    }
};
struct EpiRes {
    static constexpr bool PERM = true, AFTER_DRAIN = false;
    const float* Xin; float* X; bf16_t* XB; float* ssq_out; float scale; int mid;
    DI void operator()(const f32x4 (&acc)[2][2][4][2], const pg8::Unit& u, int wr, int wc, int fr, int fq) const {
        const int row0 = u.pm * 256 + wr * 64 + fr, col0 = u.pn * 256 + wc * 32 + 8 * fq;
#pragma unroll
        for (int ai = 0; ai < 2; ++ai)
#pragma unroll
            for (int m = 0; m < 4; ++m) {
                const int row = row0 + ai * 128 + m * 16;
                float sq = 0.f;
#pragma unroll
                for (int bj = 0; bj < 2; ++bj) {
                    const size_t off = (size_t)row * D + col0 + bj * 128;
                    f32x4 a, b;
                    if (mid) { a = *(const f32x4*)(Xin + off); b = *(const f32x4*)(Xin + off + 4); }
                    else { const u32x4 h = *(const u32x4*)(XB + off); a = (f32x4){bflo(h.x), bfhi(h.x), bflo(h.y), bfhi(h.y)}; b = (f32x4){bflo(h.z), bfhi(h.z), bflo(h.w), bfhi(h.w)}; }
                    a += acc[ai][bj][m][0] * scale; b += acc[ai][bj][m][1] * scale;
                    if (!mid) { *(f32x4*)(X + off) = a; *(f32x4*)(X + off + 4) = b; }
                    sq += (a[0] * a[0] + a[1] * a[1]) + (a[2] * a[2] + a[3] * a[3]) + (b[0] * b[0] + b[1] * b[1]) + (b[2] * b[2] + b[3] * b[3]);
                    u32x4 w; w.x = pk(a[0], a[1]); w.y = pk(a[2], a[3]); w.z = pk(b[0], b[1]); w.w = pk(b[2], b[3]);
                    *(u32x4*)(XB + off) = w;
                }
                sq += __shfl_xor(sq, 16); sq += __shfl_xor(sq, 32);
                if (fq == 0) ssq_out[(size_t)row * 16 + u.pn * 4 + wc] = sq;
            }
    }
};

DI void transpose_item(const float* __restrict__ W, int K, int N, int NP, const float* __restrict__ g, bf16_t* WT, LAS float* scr, int item, int lane) {
    const int nblk = NP / 32, kb = item / nblk, nb = item % nblk, k0 = 64 * kb, n0 = 32 * nb;
    const int n = n0 + (lane & 31);
#pragma unroll
    for (int i = 0; i < 32; ++i) {
        const int kk = 2 * i + (lane >> 5);
        float v = (n < N) ? __builtin_nontemporal_load(W + (size_t)(k0 + kk) * N + n) : 0.f;
        if (g) v *= g[k0 + kk];
        scr[kk * 33 + (lane & 31)] = v;
    }
    LDS_WAIT();
    const int c = lane & 7;
#pragma unroll
    for (int j = 0; j < 4; ++j) {
        const int nn = (lane >> 3) + 8 * j; const LAS float* s = scr + (8 * c) * 33 + nn;
        u32x4 o; o.x = pk(s[0 * 33], s[1 * 33]); o.y = pk(s[2 * 33], s[3 * 33]); o.z = pk(s[4 * 33], s[5 * 33]); o.w = pk(s[6 * 33], s[7 * 33]);
        *(u32x4*)(WT + (size_t)(n0 + nn) * K + k0 + 8 * c) = o;
    }
    LDS_WAIT();
}

struct Args {
    const float* x; const float* ln1_g; const float* w_in; const float* conv_w; const float* q_norm_g; const float* k_norm_g; const float* diff_lambda;
    const float* diff_subln_g; const float* gla_alpha_w; const float* gla_alpha_b; const float* gla_norm_g; const float* w_out; const float* ln2_g;
    const float* w_mlp1; const float* w_mlp2; float* out; unsigned char* ws;
};

DI void prologue(const Args& a, ldsp lds, int tid, int G, int bid) {
    const int lane = tid & 63, wave = tid >> 6;
    LAS float* scr = (LAS float*)(lds + wave * 16384);
    const int gw = bid * 8 + wave, NGW = G * 8;
    constexpr int I_IN = (D / 64) * (ZLD / 32), I_OUT = (D / 64) * (D / 32), I_1 = (D / 64) * (FF / 32), I_2 = (FF / 64) * (D / 32);
    constexpr int I_L = I_IN + I_OUT + I_1 + I_2;
    for (int it = gw; it < DEPTH * I_L; it += NGW) {
        const int l = it / I_L; int r = it % I_L;
        bf16_t* wt = (bf16_t*)(a.ws + WS_WT + (size_t)l * LW);
        if (r < I_IN) { transpose_item(a.w_in + (size_t)l * D * DIN, D, DIN, ZLD, a.ln1_g + l * D, wt, scr, r, lane); continue; } r -= I_IN;
        wt += LW_IN / 2;
        if (r < I_OUT) { transpose_item(a.w_out + (size_t)l * D * D, D, D, D, nullptr, wt, scr, r, lane); continue; } r -= I_OUT;
        wt += LW_OUT / 2;
        if (r < I_1) { transpose_item(a.w_mlp1 + (size_t)l * D * FF, D, FF, FF, a.ln2_g + l * D, wt, scr, r, lane); continue; } r -= I_1;
        wt += LW_1 / 2;
        transpose_item(a.w_mlp2 + (size_t)l * FF * D, FF, D, D, nullptr, wt, scr, r, lane);
    }
    bf16_t* XB = (bf16_t*)(a.ws + WS_XB); float* ssq1 = (float*)(a.ws + WS_SSQ1);
    if (bid == 0 && tid < DEPTH * 16) ((unsigned*)(a.ws + WS_CTR))[tid * 64] = 0u;
    for (int m = gw; m < M; m += NGW) {
        const f32x4* xr = (const f32x4*)(a.x + (size_t)m * D) + lane;
        u32x2* xb = (u32x2*)(XB + (size_t)m * D) + lane;
        float s = 0.f;
#pragma unroll
        for (int j = 0; j < 4; ++j) {
            const f32x4 v = xr[64 * j]; s += (v[0] * v[0] + v[1] * v[1]) + (v[2] * v[2] + v[3] * v[3]);
            u32x2 o; o.x = pk(v[0], v[1]); o.y = pk(v[2], v[3]); xb[64 * j] = o;
        }
#pragma unroll
        for (int o = 1; o < 64; o <<= 1) s += __shfl_xor(s, o);
        if (lane < 16) ssq1[(size_t)m * 16 + lane] = lane == 0 ? s : 0.f;
    }
}

DI void unpack8(const u32x4 v, float (&f)[8]) {
    f[0] = bflo(v.x); f[1] = bfhi(v.x); f[2] = bflo(v.y); f[3] = bfhi(v.y); f[4] = bflo(v.z); f[5] = bfhi(v.z); f[6] = bflo(v.w); f[7] = bfhi(v.w);
}
DI u32x4 pack8(const float (&f)[8]) { u32x4 o; o.x = pk(f[0], f[1]); o.y = pk(f[2], f[3]); o.z = pk(f[4], f[5]); o.w = pk(f[6], f[7]); return o; }

DI void qk_norm(bf16_t* z, const float* qg, const float* kg, int tid, int G, int bid) {
    const int sub = tid & 127, vec = sub >> 3, l8 = sub & 7;
    const float* g = (vec < 8 ? qg : kg) + l8 * 8;
    float gv[8];
#pragma unroll
    for (int j = 0; j < 8; ++j) gv[j] = g[j] * (vec < 8 ? LOG2E * 0.125f : 1.0f);
    for (int it = bid; it < M / 32; it += G) {
        u32x4* p[8]; u32x4 v[8];
#pragma unroll
        for (int k = 0; k < 8; ++k) { p[k] = (u32x4*)(z + (size_t)(it * 32 + k * 4 + (tid >> 7)) * ZLD + C_DQ + vec * 64 + l8 * 8); v[k] = *p[k]; }
#pragma unroll
        for (int k = 0; k < 8; ++k) {
            float f[8]; unpack8(v[k], f);
            float ss = 0.f;
#pragma unroll
            for (int j = 0; j < 8; ++j) ss += f[j] * f[j];
            ss += __shfl_xor(ss, 1); ss += __shfl_xor(ss, 2); ss += __shfl_xor(ss, 4);
            const float r = rsqrtf(ss * (1.0f / 64.0f) + EPS);
#pragma unroll
            for (int j = 0; j < 8; ++j) f[j] = f[j] * r * gv[j];
            *p[k] = pack8(f);
        }
    }
}

DI void v_transpose(const bf16_t* z, bf16_t* VT, ldsp lds, int tid, int G, int bid) {
    for (int u = bid; u < 2048; u += G) {
        const int b = u >> 9, h = (u >> 7) & 3, tile = u & 127;
        __syncthreads();
#pragma unroll
        for (int i = 0; i < 2; ++i) {
            const int p = tid + 512 * i, tok = p >> 4, c16 = p & 15;
            const u32x4 v = *(const u32x4*)(z + (size_t)(b * SEQ + tile * 64 + tok) * ZLD + C_DV + h * 128 + c16 * 8);
            *(LAS u32x4*)(lds + tok * 272 + c16 * 16) = v;
        }
        __syncthreads();
        const int e = tid & 127, tg = tid >> 7, mg = tg >> 1, h2 = tg & 1;
        unsigned lo[8], hi[8];
#pragma unroll
        for (int k = 0; k < 8; ++k) {
            lo[k] = *(LAS bf16_t*)(lds + (32 * mg + 8 * h2 + k) * 272 + e * 2);
            hi[k] = *(LAS bf16_t*)(lds + (32 * mg + 16 + 8 * h2 + k) * 272 + e * 2);
        }
        u32x4* dst = (u32x4*)(VT + (size_t)((b * 4 + h) * 128 + e) * SEQ + tile * 64 + 32 * mg + 16 * h2);
        u32x4 o0, o1;
        o0.x = lo[0] | (lo[1] << 16); o0.y = lo[2] | (lo[3] << 16); o0.z = hi[0] | (hi[1] << 16); o0.w = hi[2] | (hi[3] << 16);
        o1.x = lo[4] | (lo[5] << 16); o1.y = lo[6] | (lo[7] << 16); o1.z = hi[4] | (hi[5] << 16); o1.w = hi[6] | (hi[7] << 16);
        dst[0] = o0; dst[1] = o1;
    }
}

DI void conv_phase(const bf16_t* z, bf16_t* Y, const float* cw, int tid, int G, int bid) {
    for (int idx = bid * 512 + tid; idx < M * 32; idx += G * 512) {
        const int tok = idx >> 5, cg8 = idx & 31, t = tok & (SEQ - 1);
        const bf16_t* zp = z + (size_t)tok * ZLD + cg8 * 8;
        float u0[8], c0[8], u1[8], c1[8], u2[8], c2[8], cb[8];
        unpack8(*(const u32x4*)(zp + C_U), u0); unpack8(*(const u32x4*)(zp + C_CC), c0); unpack8(*(const u32x4*)(zp + C_CB), cb);
        const bool h1 = t >= 1, h2 = t >= 2;
        const u32x4 zero = {0u, 0u, 0u, 0u};
        unpack8(h1 ? *(const u32x4*)(zp - ZLD + C_U) : zero, u1); unpack8(h1 ? *(const u32x4*)(zp - ZLD + C_CC) : zero, c1);
        unpack8(h2 ? *(const u32x4*)(zp - 2 * ZLD + C_U) : zero, u2); unpack8(h2 ? *(const u32x4*)(zp - 2 * ZLD + C_CC) : zero, c2);
        float o[8];
#pragma unroll
        for (int j = 0; j < 8; ++j) {
            const int c = cg8 * 8 + j;
            o[j] = cb[j] * (cw[2 * 256 + c] * (c0[j] * u0[j]) + cw[256 + c] * (c1[j] * u1[j]) + cw[c] * (c2[j] * u2[j]));
        }
        *(u32x4*)(Y + (size_t)tok * D + cg8 * 8) = pack8(o);
    }
}

#define MFMA16(a, b, c) __builtin_amdgcn_mfma_f32_16x16x32_bf16((a), (b), (c), 0, 0, 0)
#define MFMA32(a, b, c) __builtin_amdgcn_mfma_f32_32x32x16_bf16((a), (b), (c), 0, 0, 0)

DI void gla_scan(float* ST, const float* DEC, int tid, int G, int bid) {
    for (int u = bid; u < 128; u += G) {
        const int p = u >> 3, el = (u & 7) * 512 + tid, d = el & 63;
        float* st = ST + (size_t)p * 128 * 4096 + el; const float* dc = DEC + (size_t)p * 128 * 64 + d;
        float* so = st;
        float s = 0.f;
        for (int c0 = 0; c0 < 128; c0 += 32) {
            float kv[32], de[32];
#pragma unroll
            for (int i = 0; i < 32; ++i) { kv[i] = st[(size_t)(c0 + i) * 4096]; de[i] = dc[(c0 + i) * 64]; }
#pragma unroll
            for (int i = 0; i < 32; ++i) { so[(size_t)(c0 + i) * 4096] = s; s = de[i] * s + kv[i]; }
        }
    }
}

constexpr int G4_HEAD = 27648, G4_R1 = 9216, G4_R2 = 18432, G4_ALR = 110592, G4_TOT = 114688;
DI float log_sigmoid_fast(float x) { return fminf(x, 0.f) - __logf(1.0f + __expf(-fabsf(x))); }

template <int MODE>
DI void gla4_unit(const bf16_t* z, float* ST, float* DEC, bf16_t* Y, const float* aw_g, const float* ab_g, const float* ng, ldsp lds, int tid, int u) {
    const int b = u >> 7, c = u & 127, tok0 = b * SEQ + c * 64;
    const int hd = tid >> 7, d = tid & 63, half = (tid >> 6) & 1, lane = tid & 63, fr = lane & 15, fq = lane >> 4;
    const int p = b * 4 + hd;
    const ldsp hr = lds + hd * G4_HEAD;
    LAS float* alr = (LAS float*)(lds + G4_ALR); LAS float* tot = (LAS float*)(lds + G4_TOT);
    __syncthreads();
    {
        constexpr int NM = MODE ? 3 : 2;
#pragma unroll
        for (int i = 0; i < NM * 4; ++i) {
            const int pi = tid + 512 * i, mh = pi >> 9, mat = mh >> 2, head = mh & 3, row = (pi >> 3) & 63, pc = pi & 7;
            const int col = (MODE ? (mat == 0 ? C_GQ : (mat == 1 ? C_GK : C_GV)) : (mat == 0 ? C_GK : C_GV)) + head * 64 + pc * 8;
            const int reg = MODE ? mat * 9216 : (mat == 0 ? 0 : G4_R2);
            *(LAS u32x4*)(lds + head * G4_HEAD + reg + row * 144 + pc * 16) = *(const u32x4*)(z + (size_t)(tok0 + row) * ZLD + col);
        }
        const int idx = tid * 2, t = idx >> 4, r = idx & 15;
        const unsigned v = *(const unsigned*)(z + (size_t)(tok0 + t) * ZLD + C_GA + r);
        alr[t * 16 + r] = bflo(v); alr[t * 16 + r + 1] = bfhi(v);
    }
    float aw[16];
#pragma unroll
    for (int r = 0; r < 16; ++r) aw[r] = aw_g[r * 256 + hd * 64 + d];
    const float ab = ab_g[hd * 64 + d];
    __syncthreads();
    float bc[32];
    {
        float run = 0.f;
#pragma unroll
        for (int i = 0; i < 32; ++i) {
            const int t = 32 * half + i;
            float al = ab;
#pragma unroll
            for (int r = 0; r < 16; ++r) al += alr[t * 16 + r] * aw[r];
            run += log_sigmoid_fast(al) * (1.0f / 16.0f);
            bc[i] = run;
        }
        tot[half * 256 + hd * 64 + d] = run;
    }
    __syncthreads();
    const float t0 = tot[hd * 64 + d], t1 = tot[256 + hd * 64 + d];
    const float pre = half ? t0 : 0.f, blast = t0 + t1;
    if (MODE == 0) {
#pragma unroll
        for (int j = 0; j < 4; ++j) {
            float f[8];
#pragma unroll
            for (int k = 0; k < 8; ++k) { const int i = 8 * j + k; f[k] = bf1(*(LAS bf16_t*)(hr + (32 * half + i) * 144 + d * 2)) * __expf(blast - (bc[i] + pre)); }
            *(LAS u32x4*)(hr + G4_R1 + d * 144 + (32 * half + 8 * j) * 2) = pack8(f);
        }
        if (half == 0) DEC[(size_t)(p * 128 + c) * 64 + d] = __expf(blast);
        __syncthreads();
#pragma unroll
        for (int j = 0; j < 4; ++j) {
            unsigned w[4];
#pragma unroll
            for (int k = 0; k < 4; ++k) {
                const unsigned lo = *(LAS bf16_t*)(hr + G4_R2 + (32 * half + 8 * j + 2 * k) * 144 + d * 2), hi = *(LAS bf16_t*)(hr + G4_R2 + (32 * half + 8 * j + 2 * k + 1) * 144 + d * 2);
                w[k] = lo | (hi << 16);
            }
            u32x4 o; o.x = w[0]; o.y = w[1]; o.z = w[2]; o.w = w[3];
            *(LAS u32x4*)(hr + d * 144 + (32 * half + 8 * j) * 2) = o;
        }
        __syncthreads();
        f32x4 acc[2][4];
#pragma unroll
        for (int rt = 0; rt < 2; ++rt)
#pragma unroll
            for (int nt = 0; nt < 4; ++nt) acc[rt][nt] = (f32x4){0.f, 0.f, 0.f, 0.f};
#pragma unroll
        for (int ks = 0; ks < 2; ++ks) {
            bf16x8 af[2], bfm[4];
#pragma unroll
            for (int rt = 0; rt < 2; ++rt) af[rt] = *(LAS bf16x8*)(hr + G4_R1 + (32 * half + 16 * rt + fr) * 144 + (32 * ks + 8 * fq) * 2);
#pragma unroll
            for (int nt = 0; nt < 4; ++nt) bfm[nt] = *(LAS bf16x8*)(hr + (16 * nt + fr) * 144 + (32 * ks + 8 * fq) * 2);
#pragma unroll
            for (int rt = 0; rt < 2; ++rt)
#pragma unroll
                for (int nt = 0; nt < 4; ++nt) acc[rt][nt] = MFMA16(af[rt], bfm[nt], acc[rt][nt]);
        }
        float* st = ST + (size_t)(p * 128 + c) * 4096;
#pragma unroll
        for (int rt = 0; rt < 2; ++rt)
#pragma unroll
            for (int nt = 0; nt < 4; ++nt) *(f32x4*)(st + (16 * nt + fr) * 64 + 32 * half + 16 * rt + 4 * fq) = acc[rt][nt];
    } else {
#pragma unroll
        for (int i = 0; i < 32; ++i) {
            const float bb = bc[i] + pre;
            LAS bf16_t* qp = (LAS bf16_t*)(hr + (32 * half + i) * 144 + d * 2); LAS bf16_t* kp = (LAS bf16_t*)(hr + G4_R1 + (32 * half + i) * 144 + d * 2);
            *qp = f2bf(bf1(*qp) * 0.125f * __expf(bb)); *kp = f2bf(bf1(*kp) * __expf(-bb));
        }
        __syncthreads();
        f32x4 acc[2][4];
#pragma unroll
        for (int rt = 0; rt < 2; ++rt)
#pragma unroll
            for (int nt = 0; nt < 4; ++nt) acc[rt][nt] = (f32x4){0.f, 0.f, 0.f, 0.f};
#pragma unroll
        for (int ks = 0; ks < 2; ++ks) {
            bf16x8 af[2], bfm[4];
#pragma unroll
            for (int rt = 0; rt < 2; ++rt) af[rt] = *(LAS bf16x8*)(hr + (32 * half + 16 * rt + fr) * 144 + (32 * ks + 8 * fq) * 2);
#pragma unroll
            for (int nt = 0; nt < 4; ++nt) bfm[nt] = *(LAS bf16x8*)(hr + G4_R1 + (16 * nt + fr) * 144 + (32 * ks + 8 * fq) * 2);
#pragma unroll
            for (int rt = 0; rt < 2; ++rt)
#pragma unroll
                for (int nt = 0; nt < 4; ++nt) acc[rt][nt] = MFMA16(af[rt], bfm[nt], acc[rt][nt]);
        }
        unsigned vw[16];
#pragma unroll
        for (int k = 0; k < 16; ++k) {
            const unsigned lo = *(LAS bf16_t*)(hr + G4_R2 + (32 * half + 2 * k) * 144 + d * 2), hi = *(LAS bf16_t*)(hr + G4_R2 + (32 * half + 2 * k + 1) * 144 + d * 2);
            vw[k] = lo | (hi << 16);
        }
        __syncthreads();
#pragma unroll
        for (int rt = 0; rt < 2; ++rt)
#pragma unroll
            for (int nt = 0; nt < 4; ++nt)
#pragma unroll
                for (int r = 0; r < 4; ++r) {
                    const int t = 32 * half + 16 * rt + 4 * fq + r, sx = 16 * nt + fr;
                    *(LAS bf16_t*)(hr + G4_R1 + t * 144 + sx * 2) = f2bf(sx <= t ? acc[rt][nt][r] : 0.f);
                }
#pragma unroll
        for (int j = 0; j < 4; ++j) { u32x4 o; o.x = vw[4 * j]; o.y = vw[4 * j + 1]; o.z = vw[4 * j + 2]; o.w = vw[4 * j + 3]; *(LAS u32x4*)(hr + G4_R2 + d * 144 + (32 * half + 8 * j) * 2) = o; }
        __syncthreads();
#pragma unroll
        for (int rt = 0; rt < 2; ++rt)
#pragma unroll
            for (int nt = 0; nt < 4; ++nt) acc[rt][nt] = (f32x4){0.f, 0.f, 0.f, 0.f};
        const float* sp = ST + (size_t)(p * 128 + c) * 4096;
#pragma unroll
        for (int ks = 0; ks < 4; ++ks) {
            bf16x8 af[2], bfm[4];
            const int kk = (ks & 1) * 32 + 8 * fq;
#pragma unroll
            for (int rt = 0; rt < 2; ++rt) af[rt] = *(LAS bf16x8*)(hr + (ks < 2 ? G4_R1 : 0) + (32 * half + 16 * rt + fr) * 144 + kk * 2);
#pragma unroll
            for (int nt = 0; nt < 4; ++nt) {
                if (ks < 2) bfm[nt] = *(LAS bf16x8*)(hr + G4_R2 + (16 * nt + fr) * 144 + kk * 2);
                else { const f32x4 s0 = *(const f32x4*)(sp + (16 * nt + fr) * 64 + kk), s1 = *(const f32x4*)(sp + (16 * nt + fr) * 64 + kk + 4);
                       u32x4 o; o.x = pk(s0[0], s0[1]); o.y = pk(s0[2], s0[3]); o.z = pk(s1[0], s1[1]); o.w = pk(s1[2], s1[3]); bfm[nt] = __builtin_bit_cast(bf16x8, o); }
            }
#pragma unroll
            for (int rt = 0; rt < 2; ++rt)
#pragma unroll
                for (int nt = 0; nt < 4; ++nt) acc[rt][nt] = MFMA16(af[rt], bfm[nt], acc[rt][nt]);
        }
        __syncthreads();
#pragma unroll
        for (int rt = 0; rt < 2; ++rt)
#pragma unroll
            for (int nt = 0; nt < 4; ++nt)
#pragma unroll
                for (int r = 0; r < 4; ++r) *(LAS float*)(hr + (32 * half + 16 * rt + 4 * fq + r) * 272 + (16 * nt + fr) * 4) = acc[rt][nt][r];
        __syncthreads();
        {
            const int t7 = tid & 127, t = t7 >> 1, e0 = (t7 & 1) * 32;
            f32x4 o[8]; float ss = 0.f;
#pragma unroll
            for (int k = 0; k < 8; ++k) { o[k] = *(LAS f32x4*)(hr + t * 272 + (e0 + 4 * k) * 4); ss += (o[k][0] * o[k][0] + o[k][1] * o[k][1]) + (o[k][2] * o[k][2] + o[k][3] * o[k][3]); }
            ss += __shfl_xor(ss, 1);
            const float rs = rsqrtf(ss * (1.0f / 64.0f) + EPS);
#pragma unroll
            for (int k = 0; k < 4; ++k) {
                float gg[8]; unpack8(*(const u32x4*)(z + (size_t)(tok0 + t) * ZLD + C_GG + hd * 64 + e0 + 8 * k), gg);
                float ov[8];
#pragma unroll
                for (int j = 0; j < 8; ++j) {
                    const float x = j < 4 ? o[2 * k][j & 3] : o[2 * k + 1][j & 3];
                    ov[j] = x * rs * ng[e0 + 8 * k + j] * (gg[j] / (1.0f + __expf(-gg[j])));
                }
                *(u32x4*)(Y + (size_t)(tok0 + t) * D + 768 + hd * 64 + e0 + 8 * k) = pack8(ov);
            }
        }
    }
}

constexpr int AT_KT = 64 * 256, AT_VT = 128 * 128, AT_STG = AT_KT + AT_VT;
DI int crow16(int i) { return (i & 3) + 8 * (i >> 2); }

DI void attn_unit(const bf16_t* z, const bf16_t* VT, bf16_t* Y, const float* subg, ldsp lds, int tid, int b, int h, int qb, float lam, float ns, float oscale, int win) {
    const int w = __builtin_amdgcn_readfirstlane(tid >> 6), lane = tid & 63, fr = lane & 15, fq = lane >> 4;
    const int comp = w & 1, g = w >> 1;
    const int q0 = qb * 128 + g * 32, nt = 2 * qb + 2, wlast = 2 * qb + (g >> 1);
    const int jstart = max(0, (qb * 128 - win) >> 6), wfirst = max(0, (q0 - win) >> 6);
    bf16x8 qf[2][2];
#pragma unroll
    for (int qt = 0; qt < 2; ++qt)
#pragma unroll
        for (int ks = 0; ks < 2; ++ks) qf[qt][ks] = *(const bf16x8*)(z + (size_t)(b * SEQ + q0 + 16 * qt + fr) * ZLD + C_DQ + h * 128 + comp * 64 + 32 * ks + 8 * fq);
    f32x4 O[8][2];
#pragma unroll
    for (int e = 0; e < 8; ++e)
#pragma unroll
        for (int qt = 0; qt < 2; ++qt) O[e][qt] = (f32x4){0.f, 0.f, 0.f, 0.f};
    float ls0 = 0.f, ls1 = 0.f;
    const float tq0 = (float)(q0 + fr), tq1 = tq0 + 16.0f;
    const int kr = 4 * w + (lane >> 4), vr = 8 * w + (lane >> 3);
    const bf16_t* kg = z + (size_t)(b * SEQ + kr) * ZLD + C_DK + h * 128 + (((lane & 15) ^ (kr & 15)) * 8);
    const bf16_t* vg = VT + (size_t)((b * 4 + h) * 128 + vr) * SEQ + (((lane & 7) ^ ((vr >> 1) & 7)) * 8);
#define AT_DMA(j, buf) do { const ldsp sb = lds + (buf) * AT_STG; \
        __builtin_amdgcn_global_load_lds((const unsigned*)(kg + (size_t)(64 * (j)) * ZLD), (LAS unsigned*)(sb + w * 1024), 16, 0, 0); \
        __builtin_amdgcn_global_load_lds((const unsigned*)(kg + (size_t)(64 * (j) + 32) * ZLD), (LAS unsigned*)(sb + 8192 + w * 1024), 16, 0, 0); \
        __builtin_amdgcn_global_load_lds((const unsigned*)(vg + 64 * (j)), (LAS unsigned*)(sb + AT_KT + w * 1024), 16, 0, 0); \
        __builtin_amdgcn_global_load_lds((const unsigned*)(vg + (size_t)64 * SEQ + 64 * (j)), (LAS unsigned*)(sb + AT_KT + 8192 + w * 1024), 16, 0, 0); } while (0)
    int koff[2], voff[2];
#pragma unroll
    for (int ks = 0; ks < 2; ++ks) koff[ks] = fr * 256 + (((comp * 8 + 4 * ks + fq) ^ fr) * 16);
#pragma unroll
    for (int m = 0; m < 2; ++m) voff[m] = AT_KT + fr * 128 + (((4 * m + fq) ^ ((fr >> 1) & 7)) * 16);
    __syncthreads();
    AT_DMA(jstart, jstart & 1);
    asm volatile("s_waitcnt vmcnt(0)" ::: "memory");
    __syncthreads();
    for (int j = jstart; j < nt; ++j) {
        if (j + 1 < nt) AT_DMA(j + 1, (j + 1) & 1);
        if (j <= wlast && j >= wfirst) {
            const ldsp sb = lds + (j & 1) * AT_STG;
            f32x4 S[4][2];
#pragma unroll
            for (int kt = 0; kt < 4; ++kt)
#pragma unroll
                for (int qt = 0; qt < 2; ++qt) S[kt][qt] = (f32x4){0.f, 0.f, 0.f, 0.f};
            {
                bf16x8 kf[2][4];
#pragma unroll
                for (int ks = 0; ks < 2; ++ks)
#pragma unroll
                    for (int kt = 0; kt < 4; ++kt) kf[ks][kt] = *(LAS bf16x8*)(sb + koff[ks] + kt * 4096);
#pragma unroll
                for (int ks = 0; ks < 2; ++ks)
#pragma unroll
                    for (int kt = 0; kt < 4; ++kt)
#pragma unroll
                        for (int qt = 0; qt < 2; ++qt) S[kt][qt] = MFMA16(kf[ks][kt], qf[qt][ks], S[kt][qt]);
            }
            const float dl0 = (float)(64 * j + 4 * fq) - tq0, dl1 = (float)(64 * j + 4 * fq) - tq1;
#pragma unroll
            for (int m = 0; m < 2; ++m) {
                bf16x8 vf[8];
#pragma unroll
                for (int et = 0; et < 8; ++et) vf[et] = *(LAS bf16x8*)(sb + voff[m] + et * 2048);
                bf16x8 pf[2];
#pragma unroll
                for (int qt = 0; qt < 2; ++qt) {
                    const float dl = qt ? dl1 : dl0;
                    float p[8];
#pragma unroll
                    for (int i = 0; i < 8; ++i) {
                        const int kt = 2 * m + (i >> 2), r = i & 3;
                        p[i] = __builtin_amdgcn_exp2f(fmaf(fabsf(dl + (float)(16 * kt + r)), ns, S[kt][qt][r]));
                    }
                    const float sum = ((p[0] + p[1]) + (p[2] + p[3])) + ((p[4] + p[5]) + (p[6] + p[7]));
                    if (qt) ls1 += sum; else ls0 += sum;
                    u32x4 u; u.x = pk(p[0], p[1]); u.y = pk(p[2], p[3]); u.z = pk(p[4], p[5]); u.w = pk(p[6], p[7]);
                    pf[qt] = __builtin_bit_cast(bf16x8, u);
                }
#pragma unroll
                for (int et = 0; et < 8; ++et)
#pragma unroll
                    for (int qt = 0; qt < 2; ++qt) O[et][qt] = MFMA16(vf[et], pf[qt], O[et][qt]);
            }
        }
        asm volatile("s_waitcnt vmcnt(0)" ::: "memory");
        __syncthreads();
    }
#undef AT_DMA
    ls0 += __shfl_xor(ls0, 16); ls0 += __shfl_xor(ls0, 32);
    ls1 += __shfl_xor(ls1, 16); ls1 += __shfl_xor(ls1, 32);
    const float sc0 = comp ? lam / ls0 : 1.0f / ls0, sc1 = comp ? lam / ls1 : 1.0f / ls1;
    const ldsp xp = lds + g * 16384 + lane * 4;
    if (comp) {
#pragma unroll
        for (int e = 0; e < 8; ++e)
#pragma unroll
            for (int qt = 0; qt < 2; ++qt)
#pragma unroll
                for (int r = 0; r < 4; ++r) *(LAS float*)(xp + ((2 * e + qt) * 4 + r) * 256) = O[e][qt][r] * (qt ? sc1 : sc0);
    }
    __syncthreads();
    if (!comp) {
        float ss0 = 0.f, ss1 = 0.f;
#pragma unroll
        for (int e = 0; e < 8; ++e)
#pragma unroll
            for (int qt = 0; qt < 2; ++qt)
#pragma unroll
                for (int r = 0; r < 4; ++r) {
                    const float o = O[e][qt][r] * (qt ? sc1 : sc0) - *(LAS float*)(xp + ((2 * e + qt) * 4 + r) * 256);
                    O[e][qt][r] = o; if (qt) ss1 += o * o; else ss0 += o * o;
                }
        ss0 += __shfl_xor(ss0, 16); ss0 += __shfl_xor(ss0, 32);
        ss1 += __shfl_xor(ss1, 16); ss1 += __shfl_xor(ss1, 32);
        const float r0 = rsqrtf(ss0 * (1.0f / 128.0f) + EPS) * oscale, r1 = rsqrtf(ss1 * (1.0f / 128.0f) + EPS) * oscale;
#pragma unroll
        for (int qt = 0; qt < 2; ++qt) {
            bf16_t* yrow = Y + (size_t)(b * SEQ + q0 + 16 * qt + fr) * D + 256 + h * 128;
            const float rr = qt ? r1 : r0;
#pragma unroll
            for (int e = 0; e < 8; ++e) {
                const int e0 = 16 * e + 4 * fq;
                const f32x4 gn = *(const f32x4*)(subg + e0);
                u32x2 o; o.x = pk(O[e][qt][0] * rr * gn[0], O[e][qt][1] * rr * gn[1]); o.y = pk(O[e][qt][2] * rr * gn[2], O[e][qt][3] * rr * gn[3]);
                *(u32x2*)(yrow + e0) = o;
            }
        }
    }
}

__global__ void __launch_bounds__(512, 2) hybrid_fwd(Args a) {
    extern __shared__ __attribute__((aligned(16))) unsigned char lds_raw[];
    const ldsp lds = (ldsp)lds_raw;
    cg::grid_group grid = cg::this_grid();
    const int tid0 = threadIdx.x, G0 = gridDim.x, bid0 = blockIdx.x;
    unsigned char* ws = a.ws;
    bf16_t* XB = (bf16_t*)(ws + WS_XB); bf16_t* VT = (bf16_t*)(ws + WS_VT); float* ST = (float*)(ws + WS_ST);
    bf16_t* Z = (bf16_t*)(ws + WS_Z); bf16_t* H = (bf16_t*)(ws + WS_Z); bf16_t* Y = (bf16_t*)(ws + WS_Y);
    float* SSQ1 = (float*)(ws + WS_SSQ1); float* SSQ2 = (float*)(ws + WS_SSQ2); float* DEC = (float*)(ws + WS_DEC);

    if (tid0 < 16) *(LAS unsigned*)(lds + LDS_PHASE + 4 * tid0) = 0u;
    __syncthreads();
    const XcdBarrier xbar = xcd_barrier_post((unsigned*)(ws + WS_BAR), (volatile LAS unsigned*)(lds + LDS_PHASE));
    prologue(a, lds, tid0, G0, bid0);
    grid.sync();

    for (int step = 0; step < DEPTH * 7; ++step) {
        const int l = step / 7, ph = step % 7;
        int tid = tid0; asm volatile("" : "+v"(tid));
        int G = G0, bid = bid0; asm volatile("" : "+s"(G), "+s"(bid));
        const bf16_t* wt_in = (const bf16_t*)(ws + WS_WT + (size_t)l * LW);
        const bf16_t* wt_out = wt_in + LW_IN / 2; const bf16_t* wt_1 = wt_out + LW_OUT / 2; const bf16_t* wt_2 = wt_1 + LW_1 / 2;
        if (ph == 0 || ph == 5) {
            const bool up = ph == 5;
            pg8::Gemm g{XB, up ? wt_1 : wt_in, M, up ? FF : ZLD, D}; pg8::StaticOrder S; S.init(M, up ? FF : ZLD, G, bid);
            EpiScale E{up ? H : Z, up ? FF : ZLD, up ? SSQ2 : SSQ1, up ? 1 : 0};
            pg8::gemm_phase<EpiScale, pg8::StaticOrder, true, true>(lds, g, S, E);
        } else if (ph == 4 || ph == 6) {
            const bool dn = ph == 6;
            pg8::Gemm g{dn ? H : Y, dn ? wt_2 : wt_out, M, D, dn ? FF : D}; pg8::StaticOrder S; S.init(M, D, G, bid);
            EpiRes E{l == 0 ? a.x : a.out, a.out, XB, dn ? SSQ1 : SSQ2, 1.0f, dn ? 0 : 1};
            pg8::gemm_phase<EpiRes, pg8::StaticOrder, true, true>(lds, g, S, E);
        } else if (ph == 1) {
            qk_norm(Z, a.q_norm_g + l * 64, a.k_norm_g + l * 64, tid, G, bid);
            v_transpose(Z, VT, lds, tid, G, bid);
            conv_phase(Z, Y, a.conv_w + l * 3 * 256, tid, G, bid);
            for (int u = bid; u < 512; u += G) { int tu = tid; asm volatile("" : "+v"(tu)); gla4_unit<0>(Z, ST, DEC, Y, a.gla_alpha_w + (size_t)l * 16 * 256, a.gla_alpha_b + l * 256, a.gla_norm_g + l * 64, lds, tu, u); }
        } else if (ph == 2) {
            gla_scan(ST, DEC, tid, G, bid);
        } else {
            const float* lp = a.diff_lambda + l * 256;
            const int lane = tid & 63;
            float v1 = lp[lane] * lp[64 + lane], v2 = lp[128 + lane] * lp[192 + lane];
#pragma unroll
            for (int o = 1; o < 64; o <<= 1) { v1 += __shfl_xor(v1, o); v2 += __shfl_xor(v2, o); }
            const float lam_init = 0.8f - 0.6f * expf(-0.3f * (float)l);
            const float lam = expf(v1) - expf(v2) + lam_init;
            float gq = fabsf(a.q_norm_g[l * 64 + lane]), gk = fabsf(a.k_norm_g[l * 64 + lane]);
#pragma unroll
            for (int o = 1; o < 64; o <<= 1) { gq = fmaxf(gq, __shfl_xor(gq, o)); gk = fmaxf(gk, __shfl_xor(gk, o)); }
            const float smax = 8.0f * gq * gk * 1.01f;
            const int xcc = (int)(__builtin_amdgcn_s_getreg((3 << 11) | 20) & 7u);
            int it = 0;
            unsigned* ctr = (unsigned*)(ws + WS_CTR) + l * 512;
            unsigned live = 0xffu;
            for (int qi = 0; qi < 8; ++qi) {
                const int xq = (xcc + qi) & 7;
                if (qi == 1) {
                    const ldsp pm = lds + LDS_PHASE + 32;
                    if (tid < 64) {
                        const bool has = tid >= 1 && tid < 8 && __hip_atomic_load(ctr + ((xcc + tid) & 7) * 64, __ATOMIC_RELAXED, __HIP_MEMORY_SCOPE_AGENT) < 128u + 64u;
                        const unsigned long long m = __ballot(has);
                        if (tid == 0) *(LAS unsigned*)pm = (unsigned)m;
                    }
                    __syncthreads();
                    live = *(LAS unsigned*)pm;
                }
                if (!((live >> qi) & 1u)) continue;
                for (;; ++it) {
                    const ldsp slot = lds + LDS_PHASE + 16 + (it & 1) * 4;
                    if (tid == 0) *(LAS unsigned*)slot = __hip_atomic_fetch_add(ctr + xq * 64, 1u, __ATOMIC_RELAXED, __HIP_MEMORY_SCOPE_AGENT);
                    __syncthreads();
                    const int idx = (int)*(LAS unsigned*)slot;
                    if (idx >= 128 + 64) break;
                    int tu = tid; asm volatile("" : "+v"(tu));
                    if (idx < 128) {
                        const int r = 63 - (xq & 1) - 2 * (idx >> 2), h = idx & 3, b = xq >> 1;
                        const float slope = exp2f(-2.0f * (float)(h + 1));
                        const float wf = (104.0f + 2.0f * smax) / slope;
                        const int win = wf < 16384.0f ? (int)wf + 1 : 16384;
                        attn_unit(Z, VT, Y, a.diff_subln_g + l * 128, lds, tu, b, h, r, lam, -slope * LOG2E, 1.0f - lam_init, win);
                    } else {
                        gla4_unit<1>(Z, ST, DEC, Y, a.gla_alpha_w + (size_t)l * 16 * 256, a.gla_alpha_b + l * 256, a.gla_norm_g + l * 64, lds, tu, xq * 64 + idx - 128);
                    }
                }
                ++it;
            }
        }
        xcd_barrier(xbar);
    }
}

extern "C" void kernel_launch(void* const* d_in, const int* in_sizes, int n_in, void* d_out, int out_size, void* d_ws, size_t ws_size, hipStream_t stream) {
    static int grid_blocks = 0;
    if (grid_blocks == 0) {
        if (n_in != 15 || out_size != M * D || ws_size < WS_END) { fprintf(stderr, "kernel_launch: unexpected shapes (n_in %d out %d ws %zu)\n", n_in, out_size, ws_size); grid_blocks = -1; return; }
        int dev = 0, cus = 0, per_cu = 0;
        hipGetDevice(&dev);
        hipDeviceGetAttribute(&cus, hipDeviceAttributeMultiprocessorCount, dev);
        if (hipFuncSetAttribute((const void*)hybrid_fwd, hipFuncAttributeMaxDynamicSharedMemorySize, LDS_BYTES) != hipSuccess) { fprintf(stderr, "kernel_launch: hipFuncSetAttribute failed\n"); grid_blocks = -1; return; }
        if (hipOccupancyMaxActiveBlocksPerMultiprocessor(&per_cu, (const void*)hybrid_fwd, 512, LDS_BYTES) != hipSuccess || per_cu < 1) { fprintf(stderr, "kernel_launch: occupancy query gave %d\n", per_cu); per_cu = 1; }
        (void)hipGetLastError();
        grid_blocks = cus * 1;
        fprintf(stderr, "kernel_launch: cus %d per_cu %d grid %d\n", cus, per_cu, grid_blocks);
    }
    if (grid_blocks < 0) return;
    Args a{};
    a.x = (const float*)d_in[0]; a.ln1_g = (const float*)d_in[1]; a.w_in = (const float*)d_in[2]; a.conv_w = (const float*)d_in[3];
    a.q_norm_g = (const float*)d_in[4]; a.k_norm_g = (const float*)d_in[5]; a.diff_lambda = (const float*)d_in[6]; a.diff_subln_g = (const float*)d_in[7];
    a.gla_alpha_w = (const float*)d_in[8]; a.gla_alpha_b = (const float*)d_in[9]; a.gla_norm_g = (const float*)d_in[10]; a.w_out = (const float*)d_in[11];
    a.ln2_g = (const float*)d_in[12]; a.w_mlp1 = (const float*)d_in[13]; a.w_mlp2 = (const float*)d_in[14];
    a.out = (float*)d_out; a.ws = (unsigned char*)d_ws;
    if (hipMemsetAsync((char*)d_ws + WS_BAR, 0, 16384, stream) != hipSuccess) { fprintf(stderr, "kernel_launch: hipMemsetAsync failed\n"); return; }
    void* args[] = {&a};
    hipError_t e = hipLaunchCooperativeKernel((const void*)hybrid_fwd, dim3(grid_blocks), dim3(512), args, LDS_BYTES, stream);
    if (e != hipSuccess) fprintf(stderr, "kernel_launch: cooperative launch failed: %s (grid %d)\n", hipGetErrorString(e), grid_blocks);
}
```

```cpp
#include <hip/hip_runtime.h>
#include <hip/hip_cooperative_groups.h>
#include <cstdio>
#include <cstdint>
namespace cg = cooperative_groups;
namespace pg8 {
#define PG8_LAS __attribute__((address_space(3)))
typedef unsigned short bf16_t;
typedef short bf16x8 __attribute__((ext_vector_type(8)));
typedef float f32x4 __attribute__((ext_vector_type(4)));
typedef unsigned u32x4 __attribute__((ext_vector_type(4)));
constexpr int BM = 256, BK = 64, HALF = 128, HTB = HALF * BK * 2  , STAGE_BYTES = 8 * HTB, NXCD = 8, WGM = 8;

__host__ __device__ __forceinline__ int lds_byte(int r, int c) { const int st = (r >> 4) * 2 + (c >> 5), rr = r & 15, cc = c & 31, ob = rr * 64 + cc * 2; return st * 1024 + (ob ^ (((ob >> 9) & 1) << 5)); }
__host__ __device__ __forceinline__ void stage_rc(int b, int& R, int& C) { const int st = b / 1024, sb = b % 1024, swz = sb ^ (((sb >> 9) & 1) << 5); R = (st >> 1) * 16 + swz / 64; C = (st & 1) * 32 + (swz % 64) / 2; }
__host__ __device__ __forceinline__ int perm32(int rho) { const int n = rho >> 4, i = rho & 15; return 8 * (i >> 2) + 4 * n + (i & 3); }

struct Unit { int pm, pn; };
struct Gemm { const bf16_t* A; const bf16_t* Bt; int M, N, K; };

struct StaticOrder {
    int nM, nN, nwg, G, c;
    __host__ __device__ void init(int M, int N, int G_, int c_) { nM = M / BM; nN = N / BM; nwg = nM * nN; G = G_; c = c_; }
    __host__ __device__ bool next(int i, Unit& u) const {
        const long L = (long)i * G + c; if (L >= nwg) return false;
        int wgid = (int)L; { const int q = nwg / NXCD, r = nwg % NXCD, xcd = wgid % NXCD, off = wgid / NXCD; wgid = (xcd < r ? xcd * (q + 1) : r * (q + 1) + (xcd - r) * q) + off; }
        const int nig = WGM * nN, gid = wgid / nig, fm = gid * WGM, gsz = (nM - fm) < WGM ? (nM - fm) : WGM;
        u.pm = fm + ((wgid % nig) % gsz); u.pn = (wgid % nig) / gsz; return true;
    }
    __device__ __forceinline__ void a_ready(const Unit&) const {}
    __device__ __forceinline__ void done(const Unit&) const {}
};
__device__ __forceinline__ unsigned cvt_pk_bf16(float lo, float hi) { unsigned r; asm volatile("v_cvt_pk_bf16_f32 %0, %1, %2" : "=v"(r) : "v"(lo), "v"(hi)); return r; }
typedef float f32x2 __attribute__((ext_vector_type(2)));
template <class Epi, class Sched, bool ALIGN_EPI = false, bool SP2 = false>
__device__ __forceinline__ void gemm_phase(PG8_LAS unsigned char* lds, const Gemm g, const Sched& S, const Epi& E) {
    int tid = threadIdx.x; asm volatile("" : "+v"(tid));
    const int wid = __builtin_amdgcn_readfirstlane(tid >> 6), lane = tid & 63, wr = wid >> 2, wc = wid & 3, fr = lane & 15, fq = lane >> 4;
    const int K = g.K, nt = K / BK;
    unsigned voffA[2], voffB[2];
#pragma unroll
    for (int i = 0; i < 2; ++i) { int R, C; stage_rc(tid * 16 + i * 8192, R, C); const int Rb = Epi::PERM ? ((R & ~31) + perm32(R & 31)) : R;
        voffA[i] = (unsigned)(R * K + C) * 2u; voffB[i] = (unsigned)(Rb * K + C) * 2u; }
    const size_t kstep = (size_t)(BK * 2);
    const size_t hstep = (size_t)HALF * K * 2;
    const size_t tstep = 2 * hstep;
    const unsigned ldsw = (unsigned)wid * 1024u;
    const int aoff = lds_byte(wr * 64 + fr, fq * 8), boff = lds_byte(wc * 32 + fr, fq * 8);
#define PG8_SA(b, h) (((b) * 2 + (h)) * HTB)
#define PG8_SB(b, h) ((4 + (b) * 2 + (h)) * HTB)
#define PG8_STAGE(bufoff, gbase, voff) do { _Pragma("unroll") for (int _i = 0; _i < 2; ++_i) \
        __builtin_amdgcn_global_load_lds((const unsigned*)((const char*)(gbase) + (voff)[_i]), (PG8_LAS unsigned*)(lds + (bufoff) + ldsw + _i * 8192), 16, 0, 0); } while (0)
#define PG8_LDA(dst, b, h) do { _Pragma("unroll") for (int m = 0; m < 4; ++m) _Pragma("unroll") for (int k = 0; k < 2; ++k) dst[m][k] = *(const PG8_LAS bf16x8*)(lds + PG8_SA(b, h) + aoff + m * 2048 + k * 1024); } while (0)
#define PG8_LDB(dst, b, h) do { _Pragma("unroll") for (int n = 0; n < 2; ++n) _Pragma("unroll") for (int k = 0; k < 2; ++k) dst[n][k] = *(const PG8_LAS bf16x8*)(lds + PG8_SB(b, h) + boff + n * 2048 + k * 1024); } while (0)
#define PG8_MMA(ai, bj, At, Bt) do { __builtin_amdgcn_s_setprio(1); _Pragma("unroll") for (int m = 0; m < 4; ++m) _Pragma("unroll") for (int n = 0; n < 2; ++n) _Pragma("unroll") for (int k = 0; k < 2; ++k) \
        acc[ai][bj][m][n] = __builtin_amdgcn_mfma_f32_16x16x32_bf16(Bt[n][k], At[m][k], acc[ai][bj][m][n], 0, 0, 0); __builtin_amdgcn_s_setprio(0); } while (0)
#define PG8_WAIT_V(n) asm volatile("s_waitcnt vmcnt(" #n ")" ::: "memory")
#define PG8_WAIT_L(n) asm volatile("s_waitcnt lgkmcnt(" #n ")" ::: "memory")
#define PG8_BAR __builtin_amdgcn_s_barrier()
#define PG8_SCHED __builtin_amdgcn_sched_barrier(0)
    Unit cur, nxt; int ui = 0;
    if (!S.next(0, cur)) return;
    f32x4 acc[2][2][4][2];
#pragma unroll
    for (int a = 0; a < 2; ++a)
#pragma unroll
        for (int b = 0; b < 2; ++b)
#pragma unroll
            for (int m = 0; m < 4; ++m)
#pragma unroll
                for (int n = 0; n < 2; ++n) acc[a][b][m][n] = (f32x4){0.f, 0.f, 0.f, 0.f};
    bf16x8 At[4][2], B0[2][2], B1[2][2];
    const char* cA = (const char*)g.A + (size_t)cur.pm * tstep; const char* cB = (const char*)g.Bt + (size_t)cur.pn * tstep;
    S.a_ready(cur);
    if constexpr (SP2) {
        PG8_STAGE(PG8_SB(0, 0), cB, voffB); PG8_STAGE(PG8_SB(0, 1), cB + hstep, voffB); PG8_STAGE(PG8_SA(0, 0), cA, voffA); PG8_STAGE(PG8_SA(0, 1), cA + hstep, voffA);
        if (wr == 1) PG8_BAR;
        PG8_WAIT_V(2); PG8_BAR;
        PG8_STAGE(PG8_SB(1, 0), cB + kstep, voffB); PG8_STAGE(PG8_SA(1, 0), cA + kstep, voffA); PG8_STAGE(PG8_SB(1, 1), cB + hstep + kstep, voffB);
        PG8_WAIT_V(6); PG8_BAR;
    } else {
        PG8_STAGE(PG8_SB(0, 0), cB, voffB); PG8_STAGE(PG8_SA(0, 0), cA, voffA); PG8_STAGE(PG8_SB(0, 1), cB + hstep, voffB); PG8_STAGE(PG8_SA(0, 1), cA + hstep, voffA);
        if (wr == 1) PG8_BAR;
        PG8_WAIT_V(4); PG8_BAR;
        PG8_STAGE(PG8_SB(1, 0), cB + kstep, voffB); PG8_STAGE(PG8_SA(1, 0), cA + kstep, voffA); PG8_STAGE(PG8_SB(1, 1), cB + hstep + kstep, voffB);
        PG8_WAIT_V(6); PG8_BAR;
    }
    for (;;) {
        const bool has_next = S.next(ui + 1, nxt);
        const char* nA = has_next ? (const char*)g.A + (size_t)nxt.pm * tstep : cA; const char* nB = has_next ? (const char*)g.Bt + (size_t)nxt.pn * tstep : cB;
        for (int t = 0; t < nt; t += 2) {
            const bool last = (t == nt - 2);
            const char* a1 = cA + (size_t)(t + 1) * kstep;
            const char* a2 = last ? nA : cA + (size_t)(t + 2) * kstep; const char* b2 = last ? nB : cB + (size_t)(t + 2) * kstep;
            const char* a3 = a2 + kstep; const char* b3 = b2 + kstep;
            if (last && has_next) S.a_ready(nxt);
            if constexpr (SP2) {
            PG8_LDB(B0, 0, 0); PG8_LDB(B1, 0, 1); PG8_SCHED; PG8_LDA(At, 0, 0); PG8_STAGE(PG8_SA(1, 1), a1 + hstep, voffA);
            PG8_WAIT_V(8); PG8_WAIT_L(0); PG8_BAR; PG8_MMA(0, 0, At, B0); PG8_MMA(0, 1, At, B1); PG8_BAR; PG8_SCHED;
            PG8_LDA(At, 0, 1); PG8_STAGE(PG8_SB(0, 0), b2, voffB); PG8_STAGE(PG8_SB(0, 1), b2 + hstep, voffB); PG8_STAGE(PG8_SA(0, 0), a2, voffA);
            PG8_WAIT_V(8); PG8_WAIT_L(0); PG8_BAR; PG8_MMA(1, 0, At, B0); PG8_MMA(1, 1, At, B1); PG8_BAR; PG8_SCHED;
            PG8_LDB(B0, 1, 0); PG8_LDB(B1, 1, 1); PG8_SCHED; PG8_LDA(At, 1, 0); PG8_STAGE(PG8_SA(0, 1), a2 + hstep, voffA);
            PG8_WAIT_V(8); PG8_WAIT_L(0); PG8_BAR; PG8_MMA(0, 0, At, B0); PG8_MMA(0, 1, At, B1); PG8_BAR; PG8_SCHED;
            PG8_LDA(At, 1, 1); PG8_STAGE(PG8_SB(1, 0), b3, voffB); PG8_STAGE(PG8_SB(1, 1), b3 + hstep, voffB); PG8_STAGE(PG8_SA(1, 0), a3, voffA);
            PG8_WAIT_V(8); PG8_WAIT_L(0); PG8_BAR; PG8_MMA(1, 0, At, B0); PG8_MMA(1, 1, At, B1); PG8_BAR; PG8_SCHED;
            } else {
            PG8_LDB(B0, 0, 0); PG8_SCHED; PG8_LDA(At, 0, 0); PG8_STAGE(PG8_SA(1, 1), a1 + hstep, voffA);
            PG8_WAIT_L(8); PG8_BAR; PG8_WAIT_L(0); PG8_MMA(0, 0, At, B0); PG8_BAR; PG8_SCHED;
            PG8_LDB(B1, 0, 1); PG8_STAGE(PG8_SB(0, 0), b2, voffB);
            PG8_BAR; PG8_WAIT_L(0); PG8_MMA(0, 1, At, B1); PG8_BAR;
            PG8_LDA(At, 0, 1); PG8_STAGE(PG8_SA(0, 0), a2, voffA);
            PG8_BAR; PG8_WAIT_L(0); PG8_MMA(1, 0, At, B0); PG8_BAR; PG8_SCHED;
            PG8_STAGE(PG8_SB(0, 1), b2 + hstep, voffB);
            PG8_WAIT_V(6); PG8_BAR; PG8_MMA(1, 1, At, B1); PG8_BAR;
            PG8_LDB(B0, 1, 0); PG8_SCHED; PG8_LDA(At, 1, 0); PG8_STAGE(PG8_SA(0, 1), a2 + hstep, voffA);
            PG8_WAIT_L(8); PG8_BAR; PG8_WAIT_L(0); PG8_MMA(0, 0, At, B0); PG8_BAR; PG8_SCHED;
            PG8_LDB(B1, 1, 1); PG8_STAGE(PG8_SB(1, 0), b3, voffB);
            PG8_BAR; PG8_WAIT_L(0); PG8_MMA(0, 1, At, B1); PG8_BAR;
            PG8_LDA(At, 1, 1); PG8_STAGE(PG8_SA(1, 0), a3, voffA);
            PG8_BAR; PG8_WAIT_L(0); PG8_MMA(1, 0, At, B0); PG8_BAR; PG8_SCHED;
            PG8_STAGE(PG8_SB(1, 1), b3 + hstep, voffB);
            PG8_WAIT_V(6); PG8_BAR; PG8_MMA(1, 1, At, B1); PG8_BAR;
            }
        }
        if constexpr (ALIGN_EPI) { if (wr == 0) PG8_BAR; }
        if constexpr (!Epi::AFTER_DRAIN) { E(acc, cur, wr, wc, fr, fq); S.done(cur); }
        if (!has_next) break;
#pragma unroll
        for (int a = 0; a < 2; ++a)
#pragma unroll
            for (int b = 0; b < 2; ++b)
#pragma unroll
                for (int m = 0; m < 4; ++m)
#pragma unroll
                    for (int n = 0; n < 2; ++n) acc[a][b][m][n] = (f32x4){0.f, 0.f, 0.f, 0.f};
        cur = nxt; cA = nA; cB = nB; ++ui;
        if constexpr (ALIGN_EPI) { if (wr == 1) PG8_BAR; }
    }
    PG8_WAIT_V(0);
    if constexpr (!ALIGN_EPI) { if (wr == 0) PG8_BAR; }
    PG8_BAR;
    if constexpr (Epi::AFTER_DRAIN) { E.fused(acc, cur, wr, wc, fr, fq, lds, wid, lane); S.done(cur); }
#undef PG8_SA
#undef PG8_SB
#undef PG8_STAGE
#undef PG8_LDA
#undef PG8_LDB
#undef PG8_MMA
#undef PG8_WAIT_V
#undef PG8_WAIT_L
#undef PG8_BAR
#undef PG8_SCHED
}
}
#define LAS __attribute__((address_space(3)))

#define XB_TMO      128
#define XB_XCNT(j)  (256  + 64 * (j))
#define XB_XSUB(j)  (1280 + 64 * (j))
#define XB_XGEN(j)  (2304 + 64 * (j))
#define XB_TOP      3328
#define XB_TOPGEN   3392
#define XCD_BAR_WORDS 3456
#define XB_SPIN_CAP (1u << 18)

__device__ __forceinline__ unsigned xb_ld(unsigned* p)              { return __hip_atomic_load(p, __ATOMIC_RELAXED, __HIP_MEMORY_SCOPE_AGENT); }
__device__ __forceinline__ unsigned xb_add(unsigned* p, unsigned v) { return __hip_atomic_fetch_add(p, v, __ATOMIC_RELAXED, __HIP_MEMORY_SCOPE_AGENT); }
__device__ __forceinline__ unsigned xb_xcc_id() { return (unsigned)__builtin_amdgcn_s_getreg((3 << 11) | 20) & 0xFu; }
#define XB_SPIN(cond, bar) do { unsigned _sp = 0; while (cond) { __builtin_amdgcn_s_sleep(1); \
    if ((++_sp & 255u) == 0u) { if (xb_ld(&(bar)[XB_TMO])) break; if (_sp > XB_SPIN_CAP) { atomicAdd(&(bar)[XB_TMO], 1u); break; } } } } while (0)

struct XcdBarrier {
    unsigned* bar; unsigned x;
    volatile LAS unsigned* st;
};

__device__ __forceinline__ XcdBarrier xcd_barrier_post(unsigned* bar, volatile LAS unsigned* st) {
    XcdBarrier b; b.bar = bar; b.x = xb_xcc_id(); b.st = st;
    if (threadIdx.x == 0) (void)xb_add(&bar[XB_XCNT(b.x)], 1u);
    return b;
}
__device__ __forceinline__ void xcd_barrier_complete(unsigned* bar, unsigned x, unsigned& nloc, unsigned& nx) {
    const unsigned G = gridDim.x * gridDim.y * gridDim.z;
    unsigned sum, cnt, mine, sp = 0u;
    for (;;) {
        sum = 0u; cnt = 0u; mine = 0u;
#pragma unroll
        for (unsigned j = 0; j < 16; ++j) { const unsigned c = xb_ld(&bar[XB_XCNT(j)]); sum += c; cnt += (c > 0u) ? 1u : 0u; mine = (j == x) ? c : mine; }
        if (sum == G) break;
        __builtin_amdgcn_s_sleep(1);
        if ((++sp & 255u) == 0u) { if (xb_ld(&bar[XB_TMO])) break; if (sp > XB_SPIN_CAP) { atomicAdd(&bar[XB_TMO], 1u); break; } }
    }
    nloc = mine > 0u ? mine : 1u; nx = cnt > 0u ? cnt : 1u;
}

__device__ __forceinline__ void xcd_barrier(const XcdBarrier& b) {
    asm volatile("s_waitcnt vmcnt(0)" ::: "memory");
    __syncthreads();
    if (threadIdx.x == 0) {
        unsigned* bar = b.bar;
        __builtin_amdgcn_s_waitcnt(0);
        unsigned nloc = b.st[0], nx = b.st[1];
        if (nloc == 0u) { xcd_barrier_complete(bar, b.x, nloc, nx); b.st[0] = nloc; b.st[1] = nx; }
        const unsigned old = xb_add(&bar[XB_XSUB(b.x)], 1u);
        const unsigned gen = old / nloc;
        if (old + 1u == (gen + 1u) * nloc) {
            __builtin_amdgcn_fence(__ATOMIC_RELEASE, "agent");
            asm volatile("s_waitcnt vmcnt(0)" ::: "memory");
            const unsigned og = xb_add(&bar[XB_TOP], 1u);
            const unsigned tg = og / nx;
            if (og + 1u == (tg + 1u) * nx) xb_add(&bar[XB_TOPGEN], 1u);
            else XB_SPIN(xb_ld(&bar[XB_TOPGEN]) == tg, bar);
            __builtin_amdgcn_fence(__ATOMIC_ACQUIRE, "agent");
            xb_add(&bar[XB_XGEN(b.x)], 1u);
            asm volatile("s_waitcnt vmcnt(0)" ::: "memory");
        } else {
            XB_SPIN(xb_ld(&bar[XB_XGEN(b.x)]) == gen, bar);
            __builtin_amdgcn_fence(__ATOMIC_ACQUIRE, "agent");
            asm volatile("s_waitcnt vmcnt(0)" ::: "memory");
        }
    }
    __syncthreads();
}


#define DI __device__ __forceinline__
#define LAS __attribute__((address_space(3)))
typedef unsigned short bf16_t;
typedef short bf16x8 __attribute__((ext_vector_type(8)));
typedef short s16x4 __attribute__((ext_vector_type(4)));
typedef float f32x4 __attribute__((ext_vector_type(4)));
typedef float f32x16 __attribute__((ext_vector_type(16)));
typedef unsigned u32x4 __attribute__((ext_vector_type(4)));
typedef unsigned u32x2 __attribute__((ext_vector_type(2)));
typedef LAS unsigned char* ldsp;

constexpr int D = 1024, NB = 4, SEQ = 8192, DEPTH = 4, M = NB * SEQ;
constexpr int DIN = 3344, ZLD = 3584, FF = 4096;
constexpr int C_U = 0, C_CB = 256, C_CC = 512, C_DQ = 768, C_DK = 1280, C_DV = 1792, C_GQ = 2304, C_GK = 2560, C_GV = 2816, C_GG = 3072, C_GA = 3328;
constexpr float EPS = 1e-6f;
constexpr float LOG2E = 1.4426950408889634f;

constexpr size_t LW_IN = (size_t)ZLD * D * 2, LW_OUT = (size_t)D * D * 2, LW_1 = (size_t)FF * D * 2, LW_2 = (size_t)D * FF * 2;
constexpr size_t LW = LW_IN + LW_OUT + LW_1 + LW_2;
constexpr size_t WS_WT = 0;
constexpr size_t WS_XB = WS_WT + DEPTH * LW;
constexpr size_t WS_VT = WS_XB;
constexpr size_t WS_ST = WS_XB + (size_t)32 * 1024 * 1024;
constexpr size_t WS_Z = WS_XB + (size_t)M * D * 2;
constexpr size_t WS_Y = WS_Z + (size_t)M * ZLD * 2;
constexpr size_t WS_SSQ1 = WS_Y + (size_t)M * D * 2;
constexpr size_t WS_SSQ2 = WS_SSQ1 + (size_t)M * 16 * 4;
constexpr size_t WS_DEC = WS_SSQ2 + (size_t)M * 16 * 4;
constexpr size_t WS_CTR = WS_DEC + (size_t)16 * 128 * 64 * 4;
constexpr size_t WS_BAR = WS_CTR + 16384;
constexpr size_t WS_END = WS_BAR + 16384;
static_assert(WS_Z + (size_t)M * FF * 2 <= WS_SSQ1, "h overlays z and y only");
static_assert(WS_END <= (size_t)512 * 1024 * 1024, "workspace");
constexpr int LDS_PHASE = 131072, LDS_BYTES = LDS_PHASE + 64;
DI float bflo(unsigned v) { return __uint_as_float(v << 16); }
DI float bfhi(unsigned v) { return __uint_as_float(v & 0xffff0000u); }
DI float bf1(bf16_t v) { return __uint_as_float((unsigned)v << 16); }
DI unsigned pk(float lo, float hi) { return pg8::cvt_pk_bf16(lo, hi); }
DI bf16_t f2bf(float f) { return (bf16_t)(pk(f, 0.f) & 0xffffu); }
#define LDS_WAIT() asm volatile("s_waitcnt lgkmcnt(0)" ::: "memory")

struct EpiScale {
    static constexpr bool PERM = true, AFTER_DRAIN = false;
    bf16_t* O; int ldc; const float* ssq; int act;
    DI void operator()(const f32x4 (&acc)[2][2][4][2], const pg8::Unit& u, int wr, int wc, int fr, int fq) const {
        const int row0 = u.pm * 256 + wr * 64 + fr, col0 = u.pn * 256 + wc * 32 + 8 * fq;
        f32x4 pp[8];
#pragma unroll
        for (int g = 0; g < 8; ++g) pp[g] = *(const f32x4*)(ssq + (size_t)(row0 + (g >> 2) * 128 + (g & 3) * 16) * 16 + 4 * fq);
#pragma unroll
        for (int ai = 0; ai < 2; ++ai)
#pragma unroll
            for (int m = 0; m < 4; ++m) {
                const int row = row0 + ai * 128 + m * 16;
                const f32x4 p = pp[ai * 4 + m];
                float s = (p[0] + p[1]) + (p[2] + p[3]);
                s += __shfl_xor(s, 16); s += __shfl_xor(s, 32);
                const float rstd = rsqrtf(s * (1.0f / D) + EPS);
                bf16_t* rowp = O + (size_t)row * ldc + col0;
#pragma unroll
                for (int bj = 0; bj < 2; ++bj) {
                    f32x4 v0 = acc[ai][bj][m][0] * rstd, v1 = acc[ai][bj][m][1] * rstd;
                    if (act) {
#pragma unroll
                        for (int k = 0; k < 4; ++k) { float a = fmaxf(v0[k], 0.f), b = fmaxf(v1[k], 0.f); v0[k] = a * a; v1[k] = b * b; }
                    }
                    u32x4 w; w.x = pk(v0[0], v0[1]); w.y = pk(v0[2], v0[3]); w.z = pk(v1[0], v1[1]); w.w = pk(v1[2], v1[3]);
                    *(u32x4*)(rowp + bj * 128) = w;
                }
            }
    }
};
struct EpiRes {
    static constexpr bool PERM = true, AFTER_DRAIN = false;
    const float* Xin; float* X; bf16_t* XB; float* ssq_out; float scale; int mid;
    DI void operator()(const f32x4 (&acc)[2][2][4][2], const pg8::Unit& u, int wr, int wc, int fr, int fq) const {
        const int row0 = u.pm * 256 + wr * 64 + fr, col0 = u.pn * 256 + wc * 32 + 8 * fq;
#pragma unroll
        for (int ai = 0; ai < 2; ++ai)
#pragma unroll
            for (int m = 0; m < 4; ++m) {
                const int row = row0 + ai * 128 + m * 16;
                float sq = 0.f;
#pragma unroll
                for (int bj = 0; bj < 2; ++bj) {
                    const size_t off = (size_t)row * D + col0 + bj * 128;
                    f32x4 a, b;
                    if (mid) { a = *(const f32x4*)(Xin + off); b = *(const f32x4*)(Xin + off + 4); }
                    else { const u32x4 h = *(const u32x4*)(XB + off); a = (f32x4){bflo(h.x), bfhi(h.x), bflo(h.y), bfhi(h.y)}; b = (f32x4){bflo(h.z), bfhi(h.z), bflo(h.w), bfhi(h.w)}; }
                    a += acc[ai][bj][m][0] * scale; b += acc[ai][bj][m][1] * scale;
                    if (!mid) { *(f32x4*)(X + off) = a; *(f32x4*)(X + off + 4) = b; }
                    sq += (a[0] * a[0] + a[1] * a[1]) + (a[2] * a[2] + a[3] * a[3]) + (b[0] * b[0] + b[1] * b[1]) + (b[2] * b[2] + b[3] * b[3]);
                    u32x4 w; w.x = pk(a[0], a[1]); w.y = pk(a[2], a[3]); w.z = pk(b[0], b[1]); w.w = pk(b[2], b[3]);
                    *(u32x4*)(XB + off) = w;
                }
                sq += __shfl_xor(sq, 16); sq += __shfl_xor(sq, 32);
                if (fq == 0) ssq_out[(size_t)row * 16 + u.pn * 4 + wc] = sq;
            }
    }
};

DI void transpose_item(const float* __restrict__ W, int K, int N, int NP, const float* __restrict__ g, bf16_t* WT, LAS float* scr, int item, int lane) {
    const int nblk = NP / 32, kb = item / nblk, nb = item % nblk, k0 = 64 * kb, n0 = 32 * nb;
    const int n = n0 + (lane & 31);
#pragma unroll
    for (int i = 0; i < 32; ++i) {
        const int kk = 2 * i + (lane >> 5);
        float v = (n < N) ? __builtin_nontemporal_load(W + (size_t)(k0 + kk) * N + n) : 0.f;
        if (g) v *= g[k0 + kk];
        scr[kk * 33 + (lane & 31)] = v;
    }
    LDS_WAIT();
    const int c = lane & 7;
#pragma unroll
    for (int j = 0; j < 4; ++j) {
        const int nn = (lane >> 3) + 8 * j; const LAS float* s = scr + (8 * c) * 33 + nn;
        u32x4 o; o.x = pk(s[0 * 33], s[1 * 33]); o.y = pk(s[2 * 33], s[3 * 33]); o.z = pk(s[4 * 33], s[5 * 33]); o.w = pk(s[6 * 33], s[7 * 33]);
        *(u32x4*)(WT + (size_t)(n0 + nn) * K + k0 + 8 * c) = o;
    }
    LDS_WAIT();
}

struct Args {
    const float* x; const float* ln1_g; const float* w_in; const float* conv_w; const float* q_norm_g; const float* k_norm_g; const float* diff_lambda;
    const float* diff_subln_g; const float* gla_alpha_w; const float* gla_alpha_b; const float* gla_norm_g; const float* w_out; const float* ln2_g;
    const float* w_mlp1; const float* w_mlp2; float* out; unsigned char* ws;
};

DI void prologue(const Args& a, ldsp lds, int tid, int G, int bid) {
    const int lane = tid & 63, wave = tid >> 6;
    LAS float* scr = (LAS float*)(lds + wave * 16384);
    const int gw = bid * 8 + wave, NGW = G * 8;
    constexpr int I_IN = (D / 64) * (ZLD / 32), I_OUT = (D / 64) * (D / 32), I_1 = (D / 64) * (FF / 32), I_2 = (FF / 64) * (D / 32);
    constexpr int I_L = I_IN + I_OUT + I_1 + I_2;
    for (int it = gw; it < DEPTH * I_L; it += NGW) {
        const int l = it / I_L; int r = it % I_L;
        bf16_t* wt = (bf16_t*)(a.ws + WS_WT + (size_t)l * LW);
        if (r < I_IN) { transpose_item(a.w_in + (size_t)l * D * DIN, D, DIN, ZLD, a.ln1_g + l * D, wt, scr, r, lane); continue; } r -= I_IN;
        wt += LW_IN / 2;
        if (r < I_OUT) { transpose_item(a.w_out + (size_t)l * D * D, D, D, D, nullptr, wt, scr, r, lane); continue; } r -= I_OUT;
        wt += LW_OUT / 2;
        if (r < I_1) { transpose_item(a.w_mlp1 + (size_t)l * D * FF, D, FF, FF, a.ln2_g + l * D, wt, scr, r, lane); continue; } r -= I_1;
        wt += LW_1 / 2;
        transpose_item(a.w_mlp2 + (size_t)l * FF * D, FF, D, D, nullptr, wt, scr, r, lane);
    }
    bf16_t* XB = (bf16_t*)(a.ws + WS_XB); float* ssq1 = (float*)(a.ws + WS_SSQ1);
    if (bid == 0 && tid < DEPTH * 16) ((unsigned*)(a.ws + WS_CTR))[tid * 64] = 0u;
    for (int m = gw; m < M; m += NGW) {
        const f32x4* xr = (const f32x4*)(a.x + (size_t)m * D) + lane;
        u32x2* xb = (u32x2*)(XB + (size_t)m * D) + lane;
        float s = 0.f;
#pragma unroll
        for (int j = 0; j < 4; ++j) {
            const f32x4 v = xr[64 * j]; s += (v[0] * v[0] + v[1] * v[1]) + (v[2] * v[2] + v[3] * v[3]);
            u32x2 o; o.x = pk(v[0], v[1]); o.y = pk(v[2], v[3]); xb[64 * j] = o;
        }
#pragma unroll
        for (int o = 1; o < 64; o <<= 1) s += __shfl_xor(s, o);
        if (lane < 16) ssq1[(size_t)m * 16 + lane] = lane == 0 ? s : 0.f;
    }
}

DI void unpack8(const u32x4 v, float (&f)[8]) {
    f[0] = bflo(v.x); f[1] = bfhi(v.x); f[2] = bflo(v.y); f[3] = bfhi(v.y); f[4] = bflo(v.z); f[5] = bfhi(v.z); f[6] = bflo(v.w); f[7] = bfhi(v.w);
}
DI u32x4 pack8(const float (&f)[8]) { u32x4 o; o.x = pk(f[0], f[1]); o.y = pk(f[2], f[3]); o.z = pk(f[4], f[5]); o.w = pk(f[6], f[7]); return o; }

DI void qk_norm(bf16_t* z, const float* qg, const float* kg, int tid, int G, int bid) {
    const int sub = tid & 127, vec = sub >> 3, l8 = sub & 7;
    const float* g = (vec < 8 ? qg : kg) + l8 * 8;
    float gv[8];
#pragma unroll
    for (int j = 0; j < 8; ++j) gv[j] = g[j] * (vec < 8 ? LOG2E * 0.125f : 1.0f);
    for (int it = bid; it < M / 32; it += G) {
        u32x4* p[8]; u32x4 v[8];
#pragma unroll
        for (int k = 0; k < 8; ++k) { p[k] = (u32x4*)(z + (size_t)(it * 32 + k * 4 + (tid >> 7)) * ZLD + C_DQ + vec * 64 + l8 * 8); v[k] = *p[k]; }
#pragma unroll
        for (int k = 0; k < 8; ++k) {
            float f[8]; unpack8(v[k], f);
            float ss = 0.f;
#pragma unroll
            for (int j = 0; j < 8; ++j) ss += f[j] * f[j];
            ss += __shfl_xor(ss, 1); ss += __shfl_xor(ss, 2); ss += __shfl_xor(ss, 4);
            const float r = rsqrtf(ss * (1.0f / 64.0f) + EPS);
#pragma unroll
            for (int j = 0; j < 8; ++j) f[j] = f[j] * r * gv[j];
            *p[k] = pack8(f);
        }
    }
}

DI void v_transpose(const bf16_t* z, bf16_t* VT, ldsp lds, int tid, int G, int bid) {
    for (int u = bid; u < 2048; u += G) {
        const int b = u >> 9, h = (u >> 7) & 3, tile = u & 127;
        __syncthreads();
#pragma unroll
        for (int i = 0; i < 2; ++i) {
            const int p = tid + 512 * i, tok = p >> 4, c16 = p & 15;
            const u32x4 v = *(const u32x4*)(z + (size_t)(b * SEQ + tile * 64 + tok) * ZLD + C_DV + h * 128 + c16 * 8);
            *(LAS u32x4*)(lds + tok * 272 + c16 * 16) = v;
        }
        __syncthreads();
        const int e = tid & 127, tg = tid >> 7, mg = tg >> 1, h2 = tg & 1;
        unsigned lo[8], hi[8];
#pragma unroll
        for (int k = 0; k < 8; ++k) {
            lo[k] = *(LAS bf16_t*)(lds + (32 * mg + 8 * h2 + k) * 272 + e * 2);
            hi[k] = *(LAS bf16_t*)(lds + (32 * mg + 16 + 8 * h2 + k) * 272 + e * 2);
        }
        u32x4* dst = (u32x4*)(VT + (size_t)((b * 4 + h) * 128 + e) * SEQ + tile * 64 + 32 * mg + 16 * h2);
        u32x4 o0, o1;
        o0.x = lo[0] | (lo[1] << 16); o0.y = lo[2] | (lo[3] << 16); o0.z = hi[0] | (hi[1] << 16); o0.w = hi[2] | (hi[3] << 16);
        o1.x = lo[4] | (lo[5] << 16); o1.y = lo[6] | (lo[7] << 16); o1.z = hi[4] | (hi[5] << 16); o1.w = hi[6] | (hi[7] << 16);
        dst[0] = o0; dst[1] = o1;
    }
}

DI void conv_phase(const bf16_t* z, bf16_t* Y, const float* cw, int tid, int G, int bid) {
    for (int idx = bid * 512 + tid; idx < M * 32; idx += G * 512) {
        const int tok = idx >> 5, cg8 = idx & 31, t = tok & (SEQ - 1);
        const bf16_t* zp = z + (size_t)tok * ZLD + cg8 * 8;
        float u0[8], c0[8], u1[8], c1[8], u2[8], c2[8], cb[8];
        unpack8(*(const u32x4*)(zp + C_U), u0); unpack8(*(const u32x4*)(zp + C_CC), c0); unpack8(*(const u32x4*)(zp + C_CB), cb);
        const bool h1 = t >= 1, h2 = t >= 2;
        const u32x4 zero = {0u, 0u, 0u, 0u};
        unpack8(h1 ? *(const u32x4*)(zp - ZLD + C_U) : zero, u1); unpack8(h1 ? *(const u32x4*)(zp - ZLD + C_CC) : zero, c1);
        unpack8(h2 ? *(const u32x4*)(zp - 2 * ZLD + C_U) : zero, u2); unpack8(h2 ? *(const u32x4*)(zp - 2 * ZLD + C_CC) : zero, c2);
        float o[8];
#pragma unroll
        for (int j = 0; j < 8; ++j) {
            const int c = cg8 * 8 + j;
            o[j] = cb[j] * (cw[2 * 256 + c] * (c0[j] * u0[j]) + cw[256 + c] * (c1[j] * u1[j]) + cw[c] * (c2[j] * u2[j]));
        }
        *(u32x4*)(Y + (size_t)tok * D + cg8 * 8) = pack8(o);
    }
}

#define MFMA16(a, b, c) __builtin_amdgcn_mfma_f32_16x16x32_bf16((a), (b), (c), 0, 0, 0)
#define MFMA32(a, b, c) __builtin_amdgcn_mfma_f32_32x32x16_bf16((a), (b), (c), 0, 0, 0)

DI void gla_scan(float* ST, const float* DEC, int tid, int G, int bid) {
    for (int u = bid; u < 128; u += G) {
        const int p = u >> 3, el = (u & 7) * 512 + tid, d = el & 63;
        float* st = ST + (size_t)p * 128 * 4096 + el; const float* dc = DEC + (size_t)p * 128 * 64 + d;
        float* so = st;
        float s = 0.f;
        for (int c0 = 0; c0 < 128; c0 += 32) {
            float kv[32], de[32];
#pragma unroll
            for (int i = 0; i < 32; ++i) { kv[i] = st[(size_t)(c0 + i) * 4096]; de[i] = dc[(c0 + i) * 64]; }
#pragma unroll
            for (int i = 0; i < 32; ++i) { so[(size_t)(c0 + i) * 4096] = s; s = de[i] * s + kv[i]; }
        }
    }
}

constexpr int G4_HEAD = 27648, G4_R1 = 9216, G4_R2 = 18432, G4_ALR = 110592, G4_TOT = 114688;
DI float log_sigmoid_fast(float x) { return fminf(x, 0.f) - __logf(1.0f + __expf(-fabsf(x))); }

template <int MODE>
DI void gla4_unit(const bf16_t* z, float* ST, float* DEC, bf16_t* Y, const float* aw_g, const float* ab_g, const float* ng, ldsp lds, int tid, int u) {
    const int b = u >> 7, c = u & 127, tok0 = b * SEQ + c * 64;
    const int hd = tid >> 7, d = tid & 63, half = (tid >> 6) & 1, lane = tid & 63, fr = lane & 15, fq = lane >> 4;
    const int p = b * 4 + hd;
    const ldsp hr = lds + hd * G4_HEAD;
    LAS float* alr = (LAS float*)(lds + G4_ALR); LAS float* tot = (LAS float*)(lds + G4_TOT);
    __syncthreads();
    {
        constexpr int NM = MODE ? 3 : 2;
#pragma unroll
        for (int i = 0; i < NM * 4; ++i) {
            const int pi = tid + 512 * i, mh = pi >> 9, mat = mh >> 2, head = mh & 3, row = (pi >> 3) & 63, pc = pi & 7;
            const int col = (MODE ? (mat == 0 ? C_GQ : (mat == 1 ? C_GK : C_GV)) : (mat == 0 ? C_GK : C_GV)) + head * 64 + pc * 8;
            const int reg = MODE ? mat * 9216 : (mat == 0 ? 0 : G4_R2);
            *(LAS u32x4*)(lds + head * G4_HEAD + reg + row * 144 + pc * 16) = *(const u32x4*)(z + (size_t)(tok0 + row) * ZLD + col);
        }
        const int idx = tid * 2, t = idx >> 4, r = idx & 15;
        const unsigned v = *(const unsigned*)(z + (size_t)(tok0 + t) * ZLD + C_GA + r);
        alr[t * 16 + r] = bflo(v); alr[t * 16 + r + 1] = bfhi(v);
    }
    float aw[16];
#pragma unroll
    for (int r = 0; r < 16; ++r) aw[r] = aw_g[r * 256 + hd * 64 + d];
    const float ab = ab_g[hd * 64 + d];
    __syncthreads();
    float bc[32];
    {
        float run = 0.f;
#pragma unroll
        for (int i = 0; i < 32; ++i) {
            const int t = 32 * half + i;
            float al = ab;
#pragma unroll
            for (int r = 0; r < 16; ++r) al += alr[t * 16 + r] * aw[r];
            run += log_sigmoid_fast(al) * (1.0f / 16.0f);
            bc[i] = run;
        }
        tot[half * 256 + hd * 64 + d] = run;
    }
    __syncthreads();
    const float t0 = tot[hd * 64 + d], t1 = tot[256 + hd * 64 + d];
    const float pre = half ? t0 : 0.f, blast = t0 + t1;
    if (MODE == 0) {
#pragma unroll
        for (int j = 0; j < 4; ++j) {
            float f[8];
#pragma unroll
            for (int k = 0; k < 8; ++k) { const int i = 8 * j + k; f[k] = bf1(*(LAS bf16_t*)(hr + (32 * half + i) * 144 + d * 2)) * __expf(blast - (bc[i] + pre)); }
            *(LAS u32x4*)(hr + G4_R1 + d * 144 + (32 * half + 8 * j) * 2) = pack8(f);
        }
        if (half == 0) DEC[(size_t)(p * 128 + c) * 64 + d] = __expf(blast);
        __syncthreads();
#pragma unroll
        for (int j = 0; j < 4; ++j) {
            unsigned w[4];
#pragma unroll
            for (int k = 0; k < 4; ++k) {
                const unsigned lo = *(LAS bf16_t*)(hr + G4_R2 + (32 * half + 8 * j + 2 * k) * 144 + d * 2), hi = *(LAS bf16_t*)(hr + G4_R2 + (32 * half + 8 * j + 2 * k + 1) * 144 + d * 2);
                w[k] = lo | (hi << 16);
            }
            u32x4 o; o.x = w[0]; o.y = w[1]; o.z = w[2]; o.w = w[3];
            *(LAS u32x4*)(hr + d * 144 + (32 * half + 8 * j) * 2) = o;
        }
        __syncthreads();
        f32x4 acc[2][4];
#pragma unroll
        for (int rt = 0; rt < 2; ++rt)
#pragma unroll
            for (int nt = 0; nt < 4; ++nt) acc[rt][nt] = (f32x4){0.f, 0.f, 0.f, 0.f};
#pragma unroll
        for (int ks = 0; ks < 2; ++ks) {
            bf16x8 af[2], bfm[4];
#pragma unroll
            for (int rt = 0; rt < 2; ++rt) af[rt] = *(LAS bf16x8*)(hr + G4_R1 + (32 * half + 16 * rt + fr) * 144 + (32 * ks + 8 * fq) * 2);
#pragma unroll
            for (int nt = 0; nt < 4; ++nt) bfm[nt] = *(LAS bf16x8*)(hr + (16 * nt + fr) * 144 + (32 * ks + 8 * fq) * 2);
#pragma unroll
            for (int rt = 0; rt < 2; ++rt)
#pragma unroll
                for (int nt = 0; nt < 4; ++nt) acc[rt][nt] = MFMA16(af[rt], bfm[nt], acc[rt][nt]);
        }
        float* st = ST + (size_t)(p * 128 + c) * 4096;
#pragma unroll
        for (int rt = 0; rt < 2; ++rt)
#pragma unroll
            for (int nt = 0; nt < 4; ++nt) *(f32x4*)(st + (16 * nt + fr) * 64 + 32 * half + 16 * rt + 4 * fq) = acc[rt][nt];
    } else {
#pragma unroll
        for (int i = 0; i < 32; ++i) {
            const float bb = bc[i] + pre;
            LAS bf16_t* qp = (LAS bf16_t*)(hr + (32 * half + i) * 144 + d * 2); LAS bf16_t* kp = (LAS bf16_t*)(hr + G4_R1 + (32 * half + i) * 144 + d * 2);
            *qp = f2bf(bf1(*qp) * 0.125f * __expf(bb)); *kp = f2bf(bf1(*kp) * __expf(-bb));
        }
        __syncthreads();
        f32x4 acc[2][4];
#pragma unroll
        for (int rt = 0; rt < 2; ++rt)
#pragma unroll
            for (int nt = 0; nt < 4; ++nt) acc[rt][nt] = (f32x4){0.f, 0.f, 0.f, 0.f};
#pragma unroll
        for (int ks = 0; ks < 2; ++ks) {
            bf16x8 af[2], bfm[4];
#pragma unroll
            for (int rt = 0; rt < 2; ++rt) af[rt] = *(LAS bf16x8*)(hr + (32 * half + 16 * rt + fr) * 144 + (32 * ks + 8 * fq) * 2);
#pragma unroll
            for (int nt = 0; nt < 4; ++nt) bfm[nt] = *(LAS bf16x8*)(hr + G4_R1 + (16 * nt + fr) * 144 + (32 * ks + 8 * fq) * 2);
#pragma unroll
            for (int rt = 0; rt < 2; ++rt)
#pragma unroll
                for (int nt = 0; nt < 4; ++nt) acc[rt][nt] = MFMA16(af[rt], bfm[nt], acc[rt][nt]);
        }
        unsigned vw[16];
#pragma unroll
        for (int k = 0; k < 16; ++k) {
            const unsigned lo = *(LAS bf16_t*)(hr + G4_R2 + (32 * half + 2 * k) * 144 + d * 2), hi = *(LAS bf16_t*)(hr + G4_R2 + (32 * half + 2 * k + 1) * 144 + d * 2);
            vw[k] = lo | (hi << 16);
        }
        __syncthreads();
#pragma unroll
        for (int rt = 0; rt < 2; ++rt)
#pragma unroll
            for (int nt = 0; nt < 4; ++nt)
#pragma unroll
                for (int r = 0; r < 4; ++r) {
                    const int t = 32 * half + 16 * rt + 4 * fq + r, sx = 16 * nt + fr;
                    *(LAS bf16_t*)(hr + G4_R1 + t * 144 + sx * 2) = f2bf(sx <= t ? acc[rt][nt][r] : 0.f);
                }
#pragma unroll
        for (int j = 0; j < 4; ++j) { u32x4 o; o.x = vw[4 * j]; o.y = vw[4 * j + 1]; o.z = vw[4 * j + 2]; o.w = vw[4 * j + 3]; *(LAS u32x4*)(hr + G4_R2 + d * 144 + (32 * half + 8 * j) * 2) = o; }
        __syncthreads();
#pragma unroll
        for (int rt = 0; rt < 2; ++rt)
#pragma unroll
            for (int nt = 0; nt < 4; ++nt) acc[rt][nt] = (f32x4){0.f, 0.f, 0.f, 0.f};
        const float* sp = ST + (size_t)(p * 128 + c) * 4096;
#pragma unroll
        for (int ks = 0; ks < 4; ++ks) {
            bf16x8 af[2], bfm[4];
            const int kk = (ks & 1) * 32 + 8 * fq;
#pragma unroll
            for (int rt = 0; rt < 2; ++rt) af[rt] = *(LAS bf16x8*)(hr + (ks < 2 ? G4_R1 : 0) + (32 * half + 16 * rt + fr) * 144 + kk * 2);
#pragma unroll
            for (int nt = 0; nt < 4; ++nt) {
                if (ks < 2) bfm[nt] = *(LAS bf16x8*)(hr + G4_R2 + (16 * nt + fr) * 144 + kk * 2);
                else { const f32x4 s0 = *(const f32x4*)(sp + (16 * nt + fr) * 64 + kk), s1 = *(const f32x4*)(sp + (16 * nt + fr) * 64 + kk + 4);
                       u32x4 o; o.x = pk(s0[0], s0[1]); o.y = pk(s0[2], s0[3]); o.z = pk(s1[0], s1[1]); o.w = pk(s1[2], s1[3]); bfm[nt] = __builtin_bit_cast(bf16x8, o); }
            }
#pragma unroll
            for (int rt = 0; rt < 2; ++rt)
#pragma unroll
                for (int nt = 0; nt < 4; ++nt) acc[rt][nt] = MFMA16(af[rt], bfm[nt], acc[rt][nt]);
        }
        __syncthreads();
#pragma unroll
        for (int rt = 0; rt < 2; ++rt)
#pragma unroll
            for (int nt = 0; nt < 4; ++nt)
#pragma unroll
                for (int r = 0; r < 4; ++r) *(LAS float*)(hr + (32 * half + 16 * rt + 4 * fq + r) * 272 + (16 * nt + fr) * 4) = acc[rt][nt][r];
        __syncthreads();
        {
            const int t7 = tid & 127, t = t7 >> 1, e0 = (t7 & 1) * 32;
            f32x4 o[8]; float ss = 0.f;
#pragma unroll
            for (int k = 0; k < 8; ++k) { o[k] = *(LAS f32x4*)(hr + t * 272 + (e0 + 4 * k) * 4); ss += (o[k][0] * o[k][0] + o[k][1] * o[k][1]) + (o[k][2] * o[k][2] + o[k][3] * o[k][3]); }
            ss += __shfl_xor(ss, 1);
            const float rs = rsqrtf(ss * (1.0f / 64.0f) + EPS);
#pragma unroll
            for (int k = 0; k < 4; ++k) {
                float gg[8]; unpack8(*(const u32x4*)(z + (size_t)(tok0 + t) * ZLD + C_GG + hd * 64 + e0 + 8 * k), gg);
                float ov[8];
#pragma unroll
                for (int j = 0; j < 8; ++j) {
                    const float x = j < 4 ? o[2 * k][j & 3] : o[2 * k + 1][j & 3];
                    ov[j] = x * rs * ng[e0 + 8 * k + j] * (gg[j] / (1.0f + __expf(-gg[j])));
                }
                *(u32x4*)(Y + (size_t)(tok0 + t) * D + 768 + hd * 64 + e0 + 8 * k) = pack8(ov);
            }
        }
    }
}

constexpr int AT_KT = 64 * 256, AT_VT = 128 * 128, AT_STG = AT_KT + AT_VT;
DI int crow16(int i) { return (i & 3) + 8 * (i >> 2); }

DI void attn_unit(const bf16_t* z, const bf16_t* VT, bf16_t* Y, const float* subg, ldsp lds, int tid, int b, int h, int qb, float lam, float ns, float oscale, int win) {
    const int w = __builtin_amdgcn_readfirstlane(tid >> 6), lane = tid & 63, fr = lane & 15, fq = lane >> 4;
    const int comp = w & 1, g = w >> 1;
    const int q0 = qb * 128 + g * 32, nt = 2 * qb + 2, wlast = 2 * qb + (g >> 1);
    const int jstart = max(0, (qb * 128 - win) >> 6), wfirst = max(0, (q0 - win) >> 6);
    bf16x8 qf[2][2];
#pragma unroll
    for (int qt = 0; qt < 2; ++qt)
#pragma unroll
        for (int ks = 0; ks < 2; ++ks) qf[qt][ks] = *(const bf16x8*)(z + (size_t)(b * SEQ + q0 + 16 * qt + fr) * ZLD + C_DQ + h * 128 + comp * 64 + 32 * ks + 8 * fq);
    f32x4 O[8][2];
#pragma unroll
    for (int e = 0; e < 8; ++e)
#pragma unroll
        for (int qt = 0; qt < 2; ++qt) O[e][qt] = (f32x4){0.f, 0.f, 0.f, 0.f};
    float ls0 = 0.f, ls1 = 0.f;
    const float tq0 = (float)(q0 + fr), tq1 = tq0 + 16.0f;
    const int kr = 4 * w + (lane >> 4), vr = 8 * w + (lane >> 3);
    const bf16_t* kg = z + (size_t)(b * SEQ + kr) * ZLD + C_DK + h * 128 + (((lane & 15) ^ (kr & 15)) * 8);
    const bf16_t* vg = VT + (size_t)((b * 4 + h) * 128 + vr) * SEQ + (((lane & 7) ^ ((vr >> 1) & 7)) * 8);
#define AT_DMA(j, buf) do { const ldsp sb = lds + (buf) * AT_STG; \
        __builtin_amdgcn_global_load_lds((const unsigned*)(kg + (size_t)(64 * (j)) * ZLD), (LAS unsigned*)(sb + w * 1024), 16, 0, 0); \
        __builtin_amdgcn_global_load_lds((const unsigned*)(kg + (size_t)(64 * (j) + 32) * ZLD), (LAS unsigned*)(sb + 8192 + w * 1024), 16, 0, 0); \
        __builtin_amdgcn_global_load_lds((const unsigned*)(vg + 64 * (j)), (LAS unsigned*)(sb + AT_KT + w * 1024), 16, 0, 0); \
        __builtin_amdgcn_global_load_lds((const unsigned*)(vg + (size_t)64 * SEQ + 64 * (j)), (LAS unsigned*)(sb + AT_KT + 8192 + w * 1024), 16, 0, 0); } while (0)
    int koff[2], voff[2];
#pragma unroll
    for (int ks = 0; ks < 2; ++ks) koff[ks] = fr * 256 + (((comp * 8 + 4 * ks + fq) ^ fr) * 16);
#pragma unroll
    for (int m = 0; m < 2; ++m) voff[m] = AT_KT + fr * 128 + (((4 * m + fq) ^ ((fr >> 1) & 7)) * 16);
    __syncthreads();
    AT_DMA(jstart, jstart & 1);
    asm volatile("s_waitcnt vmcnt(0)" ::: "memory");
    __syncthreads();
    for (int j = jstart; j < nt; ++j) {
        if (j + 1 < nt) AT_DMA(j + 1, (j + 1) & 1);
        if (j <= wlast && j >= wfirst) {
            const ldsp sb = lds + (j & 1) * AT_STG;
            bf16x8 vf0[8], vf1[8];
#pragma unroll
            for (int et = 0; et < 8; ++et) vf0[et] = *(LAS bf16x8*)(sb + voff[0] + et * 2048);
            f32x4 S[4][2];
#pragma unroll
            for (int kt = 0; kt < 4; ++kt)
#pragma unroll
                for (int qt = 0; qt < 2; ++qt) S[kt][qt] = (f32x4){0.f, 0.f, 0.f, 0.f};
#pragma unroll
            for (int ks = 0; ks < 2; ++ks) {
                bf16x8 kf[4];
#pragma unroll
                for (int kt = 0; kt < 4; ++kt) kf[kt] = *(LAS bf16x8*)(sb + koff[ks] + kt * 4096);
#pragma unroll
                for (int kt = 0; kt < 4; ++kt)
#pragma unroll
                    for (int qt = 0; qt < 2; ++qt) S[kt][qt] = MFMA16(kf[kt], qf[qt][ks], S[kt][qt]);
            }
            const float dl0 = (float)(64 * j + 4 * fq) - tq0, dl1 = (float)(64 * j + 4 * fq) - tq1;
#define AT_EXP(m, qt, dl, dst, lsv) do { float p[8]; \
                _Pragma("unroll") for (int i = 0; i < 8; ++i) { const int kt = 2 * (m) + (i >> 2), r = i & 3; \
                    p[i] = __builtin_amdgcn_exp2f(fmaf(fabsf((dl) + (float)(16 * kt + r)), ns, S[kt][qt][r])); } \
                lsv += ((p[0] + p[1]) + (p[2] + p[3])) + ((p[4] + p[5]) + (p[6] + p[7])); \
                u32x4 u; u.x = pk(p[0], p[1]); u.y = pk(p[2], p[3]); u.z = pk(p[4], p[5]); u.w = pk(p[6], p[7]); dst = __builtin_bit_cast(bf16x8, u); } while (0)
            bf16x8 pf[2];
            AT_EXP(0, 0, dl0, pf[0], ls0); AT_EXP(0, 1, dl1, pf[1], ls1);
#pragma unroll
            for (int et = 0; et < 8; ++et) vf1[et] = *(LAS bf16x8*)(sb + voff[1] + et * 2048);
#pragma unroll
            for (int et = 0; et < 8; ++et)
#pragma unroll
                for (int qt = 0; qt < 2; ++qt) O[et][qt] = MFMA16(vf0[et], pf[qt], O[et][qt]);
            AT_EXP(1, 0, dl0, pf[0], ls0); AT_EXP(1, 1, dl1, pf[1], ls1);
#pragma unroll
            for (int et = 0; et < 8; ++et)
#pragma unroll
                for (int qt = 0; qt < 2; ++qt) O[et][qt] = MFMA16(vf1[et], pf[qt], O[et][qt]);
#undef AT_EXP
        }
        asm volatile("s_waitcnt vmcnt(0)" ::: "memory");
        __syncthreads();
    }
#undef AT_DMA
    ls0 += __shfl_xor(ls0, 16); ls0 += __shfl_xor(ls0, 32);
    ls1 += __shfl_xor(ls1, 16); ls1 += __shfl_xor(ls1, 32);
    const float sc0 = comp ? lam / ls0 : 1.0f / ls0, sc1 = comp ? lam / ls1 : 1.0f / ls1;
    const ldsp xp = lds + g * 16384 + lane * 4;
    if (comp) {
#pragma unroll
        for (int e = 0; e < 8; ++e)
#pragma unroll
            for (int qt = 0; qt < 2; ++qt)
#pragma unroll
                for (int r = 0; r < 4; ++r) *(LAS float*)(xp + ((2 * e + qt) * 4 + r) * 256) = O[e][qt][r] * (qt ? sc1 : sc0);
    }
    __syncthreads();
    if (!comp) {
        float ss0 = 0.f, ss1 = 0.f;
#pragma unroll
        for (int e = 0; e < 8; ++e)
#pragma unroll
            for (int qt = 0; qt < 2; ++qt)
#pragma unroll
                for (int r = 0; r < 4; ++r) {
                    const float o = O[e][qt][r] * (qt ? sc1 : sc0) - *(LAS float*)(xp + ((2 * e + qt) * 4 + r) * 256);
                    O[e][qt][r] = o; if (qt) ss1 += o * o; else ss0 += o * o;
                }
        ss0 += __shfl_xor(ss0, 16); ss0 += __shfl_xor(ss0, 32);
        ss1 += __shfl_xor(ss1, 16); ss1 += __shfl_xor(ss1, 32);
        const float r0 = rsqrtf(ss0 * (1.0f / 128.0f) + EPS) * oscale, r1 = rsqrtf(ss1 * (1.0f / 128.0f) + EPS) * oscale;
#pragma unroll
        for (int qt = 0; qt < 2; ++qt) {
            bf16_t* yrow = Y + (size_t)(b * SEQ + q0 + 16 * qt + fr) * D + 256 + h * 128;
            const float rr = qt ? r1 : r0;
#pragma unroll
            for (int e = 0; e < 8; ++e) {
                const int e0 = 16 * e + 4 * fq;
                const f32x4 gn = *(const f32x4*)(subg + e0);
                u32x2 o; o.x = pk(O[e][qt][0] * rr * gn[0], O[e][qt][1] * rr * gn[1]); o.y = pk(O[e][qt][2] * rr * gn[2], O[e][qt][3] * rr * gn[3]);
                *(u32x2*)(yrow + e0) = o;
            }
        }
    }
}

__global__ void __launch_bounds__(512, 2) hybrid_fwd(Args a) {
    extern __shared__ __attribute__((aligned(16))) unsigned char lds_raw[];
    const ldsp lds = (ldsp)lds_raw;
    cg::grid_group grid = cg::this_grid();
    const int tid0 = threadIdx.x, G0 = gridDim.x, bid0 = blockIdx.x;
    unsigned char* ws = a.ws;
    bf16_t* XB = (bf16_t*)(ws + WS_XB); bf16_t* VT = (bf16_t*)(ws + WS_VT); float* ST = (float*)(ws + WS_ST);
    bf16_t* Z = (bf16_t*)(ws + WS_Z); bf16_t* H = (bf16_t*)(ws + WS_Z); bf16_t* Y = (bf16_t*)(ws + WS_Y);
    float* SSQ1 = (float*)(ws + WS_SSQ1); float* SSQ2 = (float*)(ws + WS_SSQ2); float* DEC = (float*)(ws + WS_DEC);

    if (tid0 < 16) *(LAS unsigned*)(lds + LDS_PHASE + 4 * tid0) = 0u;
    __syncthreads();
    const XcdBarrier xbar = xcd_barrier_post((unsigned*)(ws + WS_BAR), (volatile LAS unsigned*)(lds + LDS_PHASE));
    prologue(a, lds, tid0, G0, bid0);
    grid.sync();

    for (int step = 0; step < DEPTH * 7; ++step) {
        const int l = step / 7, ph = step % 7;
        int tid = tid0; asm volatile("" : "+v"(tid));
        int G = G0, bid = bid0; asm volatile("" : "+s"(G), "+s"(bid));
        const bf16_t* wt_in = (const bf16_t*)(ws + WS_WT + (size_t)l * LW);
        const bf16_t* wt_out = wt_in + LW_IN / 2; const bf16_t* wt_1 = wt_out + LW_OUT / 2; const bf16_t* wt_2 = wt_1 + LW_1 / 2;
        if (ph == 0 || ph == 5) {
            const bool up = ph == 5;
            pg8::Gemm g{XB, up ? wt_1 : wt_in, M, up ? FF : ZLD, D}; pg8::StaticOrder S; S.init(M, up ? FF : ZLD, G, bid);
            EpiScale E{up ? H : Z, up ? FF : ZLD, up ? SSQ2 : SSQ1, up ? 1 : 0};
            pg8::gemm_phase<EpiScale, pg8::StaticOrder, true, true>(lds, g, S, E);
        } else if (ph == 4 || ph == 6) {
            const bool dn = ph == 6;
            pg8::Gemm g{dn ? H : Y, dn ? wt_2 : wt_out, M, D, dn ? FF : D}; pg8::StaticOrder S; S.init(M, D, G, bid);
            EpiRes E{l == 0 ? a.x : a.out, a.out, XB, dn ? SSQ1 : SSQ2, 1.0f, dn ? 0 : 1};
            pg8::gemm_phase<EpiRes, pg8::StaticOrder, true, true>(lds, g, S, E);
        } else if (ph == 1) {
            qk_norm(Z, a.q_norm_g + l * 64, a.k_norm_g + l * 64, tid, G, bid);
            v_transpose(Z, VT, lds, tid, G, bid);
            conv_phase(Z, Y, a.conv_w + l * 3 * 256, tid, G, bid);
            for (int u = bid; u < 512; u += G) { int tu = tid; asm volatile("" : "+v"(tu)); gla4_unit<0>(Z, ST, DEC, Y, a.gla_alpha_w + (size_t)l * 16 * 256, a.gla_alpha_b + l * 256, a.gla_norm_g + l * 64, lds, tu, u); }
        } else if (ph == 2) {
            gla_scan(ST, DEC, tid, G, bid);
        } else {
            const float* lp = a.diff_lambda + l * 256;
            const int lane = tid & 63;
            float v1 = lp[lane] * lp[64 + lane], v2 = lp[128 + lane] * lp[192 + lane];
#pragma unroll
            for (int o = 1; o < 64; o <<= 1) { v1 += __shfl_xor(v1, o); v2 += __shfl_xor(v2, o); }
            const float lam_init = 0.8f - 0.6f * expf(-0.3f * (float)l);
            const float lam = expf(v1) - expf(v2) + lam_init;
            float gq = fabsf(a.q_norm_g[l * 64 + lane]), gk = fabsf(a.k_norm_g[l * 64 + lane]);
#pragma unroll
            for (int o = 1; o < 64; o <<= 1) { gq = fmaxf(gq, __shfl_xor(gq, o)); gk = fmaxf(gk, __shfl_xor(gk, o)); }
            const float smax = 8.0f * gq * gk * 1.01f;
            const int xcc = (int)(__builtin_amdgcn_s_getreg((3 << 11) | 20) & 7u);
            int it = 0;
            unsigned* ctr = (unsigned*)(ws + WS_CTR) + l * 512;
            unsigned live = 0xffu;
            for (int qi = 0; qi < 8; ++qi) {
                const int xq = (xcc + qi) & 7;
                if (qi == 1) {
                    const ldsp pm = lds + LDS_PHASE + 32;
                    if (tid < 64) {
                        const bool has = tid >= 1 && tid < 8 && __hip_atomic_load(ctr + ((xcc + tid) & 7) * 64, __ATOMIC_RELAXED, __HIP_MEMORY_SCOPE_AGENT) < 128u + 64u;
                        const unsigned long long m = __ballot(has);
                        if (tid == 0) *(LAS unsigned*)pm = (unsigned)m;
                    }
                    __syncthreads();
                    live = *(LAS unsigned*)pm;
                }
                if (!((live >> qi) & 1u)) continue;
                for (;; ++it) {
                    const ldsp slot = lds + LDS_PHASE + 16 + (it & 1) * 4;
                    if (tid == 0) *(LAS unsigned*)slot = __hip_atomic_fetch_add(ctr + xq * 64, 1u, __ATOMIC_RELAXED, __HIP_MEMORY_SCOPE_AGENT);
                    __syncthreads();
                    const int idx = (int)*(LAS unsigned*)slot;
                    if (idx >= 128 + 64) break;
                    int tu = tid; asm volatile("" : "+v"(tu));
                    if (idx < 128) {
                        const int r = 63 - (xq & 1) - 2 * (idx >> 2), h = idx & 3, b = xq >> 1;
                        const float slope = exp2f(-2.0f * (float)(h + 1));
                        const float wf = (104.0f + 2.0f * smax) / slope;
                        const int win = wf < 16384.0f ? (int)wf + 1 : 16384;
                        attn_unit(Z, VT, Y, a.diff_subln_g + l * 128, lds, tu, b, h, r, lam, -slope * LOG2E, 1.0f - lam_init, win);
                    } else {
                        gla4_unit<1>(Z, ST, DEC, Y, a.gla_alpha_w + (size_t)l * 16 * 256, a.gla_alpha_b + l * 256, a.gla_norm_g + l * 64, lds, tu, xq * 64 + idx - 128);
                    }
                }
                ++it;
            }
        }
        xcd_barrier(xbar);
    }
}

extern "C" void kernel_launch(void* const* d_in, const int* in_sizes, int n_in, void* d_out, int out_size, void* d_ws, size_t ws_size, hipStream_t stream) {
    static int grid_blocks = 0;
    if (grid_blocks == 0) {
        if (n_in != 15 || out_size != M * D || ws_size < WS_END) { fprintf(stderr, "kernel_launch: unexpected shapes (n_in %d out %d ws %zu)\n", n_in, out_size, ws_size); grid_blocks = -1; return; }
        int dev = 0, cus = 0, per_cu = 0;
        hipGetDevice(&dev);
        hipDeviceGetAttribute(&cus, hipDeviceAttributeMultiprocessorCount, dev);
        if (hipFuncSetAttribute((const void*)hybrid_fwd, hipFuncAttributeMaxDynamicSharedMemorySize, LDS_BYTES) != hipSuccess) { fprintf(stderr, "kernel_launch: hipFuncSetAttribute failed\n"); grid_blocks = -1; return; }
        if (hipOccupancyMaxActiveBlocksPerMultiprocessor(&per_cu, (const void*)hybrid_fwd, 512, LDS_BYTES) != hipSuccess || per_cu < 1) { fprintf(stderr, "kernel_launch: occupancy query gave %d\n", per_cu); per_cu = 1; }
        (void)hipGetLastError();
        grid_blocks = cus * 1;
        fprintf(stderr, "kernel_launch: cus %d per_cu %d grid %d\n", cus, per_cu, grid_blocks);
    }
    if (grid_blocks < 0) return;
    Args a{};
    a.x = (const float*)d_in[0]; a.ln1_g = (const float*)d_in[1]; a.w_in = (const float*)d_in[2]; a.conv_w = (const float*)d_in[3];
    a.q_norm_g = (const float*)d_in[4]; a.k_norm_g = (const float*)d_in[5]; a.diff_lambda = (const float*)d_in[6]; a.diff_subln_g = (const float*)d_in[7];
    a.gla_alpha_w = (const float*)d_in[8]; a.gla_alpha_b = (const float*)d_in[9]; a.gla_norm_g = (const float*)d_in[10]; a.w_out = (const float*)d_in[11];
    a.ln2_g = (const float*)d_in[12]; a.w_mlp1 = (const float*)d_in[13]; a.w_mlp2 = (const float*)d_in[14];
    a.out = (float*)d_out; a.ws = (unsigned char*)d_ws;
    if (hipMemsetAsync((char*)d_ws + WS_BAR, 0, 16384, stream) != hipSuccess) { fprintf(stderr, "kernel_launch: hipMemsetAsync failed\n"); return; }
    void* args[] = {&a};
    hipError_t e = hipLaunchCooperativeKernel((const void*)hybrid_fwd, dim3(grid_blocks), dim3(512), args, LDS_BYTES, stream);
    if (e != hipSuccess) fprintf(stderr, "kernel_launch: cooperative launch failed: %s (grid %d)\n", hipGetErrorString(e), grid_blocks);
}
```

```cpp
#include <hip/hip_runtime.h>
#include <hip/hip_cooperative_groups.h>
#include <cstdio>
#include <cstdint>
namespace cg = cooperative_groups;
namespace pg8 {
#define PG8_LAS __attribute__((address_space(3)))
typedef unsigned short bf16_t;
typedef short bf16x8 __attribute__((ext_vector_type(8)));
typedef float f32x4 __attribute__((ext_vector_type(4)));
typedef unsigned u32x4 __attribute__((ext_vector_type(4)));
constexpr int BM = 256, BK = 64, HALF = 128, HTB = HALF * BK * 2  , STAGE_BYTES = 8 * HTB, NXCD = 8, WGM = 8;

__host__ __device__ __forceinline__ int lds_byte(int r, int c) { const int st = (r >> 4) * 2 + (c >> 5), rr = r & 15, cc = c & 31, ob = rr * 64 + cc * 2; return st * 1024 + (ob ^ (((ob >> 9) & 1) << 5)); }
__host__ __device__ __forceinline__ void stage_rc(int b, int& R, int& C) { const int st = b / 1024, sb = b % 1024, swz = sb ^ (((sb >> 9) & 1) << 5); R = (st >> 1) * 16 + swz / 64; C = (st & 1) * 32 + (swz % 64) / 2; }
__host__ __device__ __forceinline__ int perm32(int rho) { const int n = rho >> 4, i = rho & 15; return 8 * (i >> 2) + 4 * n + (i & 3); }

struct Unit { int pm, pn; };
struct Gemm { const bf16_t* A; const bf16_t* Bt; int M, N, K; };

struct StaticOrder {
    int nM, nN, nwg, G, c;
    __host__ __device__ void init(int M, int N, int G_, int c_) { nM = M / BM; nN = N / BM; nwg = nM * nN; G = G_; c = c_; }
    __host__ __device__ bool next(int i, Unit& u) const {
        const long L = (long)i * G + c; if (L >= nwg) return false;
        int wgid = (int)L; { const int q = nwg / NXCD, r = nwg % NXCD, xcd = wgid % NXCD, off = wgid / NXCD; wgid = (xcd < r ? xcd * (q + 1) : r * (q + 1) + (xcd - r) * q) + off; }
        const int nig = WGM * nN, gid = wgid / nig, fm = gid * WGM, gsz = (nM - fm) < WGM ? (nM - fm) : WGM;
        u.pm = fm + ((wgid % nig) % gsz); u.pn = (wgid % nig) / gsz; return true;
    }
    __device__ __forceinline__ void a_ready(const Unit&) const {}
    __device__ __forceinline__ void done(const Unit&) const {}
};
__device__ __forceinline__ unsigned cvt_pk_bf16(float lo, float hi) { unsigned r; asm volatile("v_cvt_pk_bf16_f32 %0, %1, %2" : "=v"(r) : "v"(lo), "v"(hi)); return r; }
typedef float f32x2 __attribute__((ext_vector_type(2)));
template <class Epi, class Sched, bool ALIGN_EPI = false, bool SP2 = false>
__device__ __forceinline__ void gemm_phase(PG8_LAS unsigned char* lds, const Gemm g, const Sched& S, const Epi& E) {
    int tid = threadIdx.x; asm volatile("" : "+v"(tid));
    const int wid = __builtin_amdgcn_readfirstlane(tid >> 6), lane = tid & 63, wr = wid >> 2, wc = wid & 3, fr = lane & 15, fq = lane >> 4;
    const int K = g.K, nt = K / BK;
    unsigned voffA[2], voffB[2];
#pragma unroll
    for (int i = 0; i < 2; ++i) { int R, C; stage_rc(tid * 16 + i * 8192, R, C); const int Rb = Epi::PERM ? ((R & ~31) + perm32(R & 31)) : R;
        voffA[i] = (unsigned)(R * K + C) * 2u; voffB[i] = (unsigned)(Rb * K + C) * 2u; }
    const size_t kstep = (size_t)(BK * 2);
    const size_t hstep = (size_t)HALF * K * 2;
    const size_t tstep = 2 * hstep;
    const unsigned ldsw = (unsigned)wid * 1024u;
    const int aoff = lds_byte(wr * 64 + fr, fq * 8), boff = lds_byte(wc * 32 + fr, fq * 8);
#define PG8_SA(b, h) (((b) * 2 + (h)) * HTB)
#define PG8_SB(b, h) ((4 + (b) * 2 + (h)) * HTB)
#define PG8_STAGE(bufoff, gbase, voff) do { _Pragma("unroll") for (int _i = 0; _i < 2; ++_i) \
        __builtin_amdgcn_global_load_lds((const unsigned*)((const char*)(gbase) + (voff)[_i]), (PG8_LAS unsigned*)(lds + (bufoff) + ldsw + _i * 8192), 16, 0, 0); } while (0)
#define PG8_LDA(dst, b, h) do { _Pragma("unroll") for (int m = 0; m < 4; ++m) _Pragma("unroll") for (int k = 0; k < 2; ++k) dst[m][k] = *(const PG8_LAS bf16x8*)(lds + PG8_SA(b, h) + aoff + m * 2048 + k * 1024); } while (0)
#define PG8_LDB(dst, b, h) do { _Pragma("unroll") for (int n = 0; n < 2; ++n) _Pragma("unroll") for (int k = 0; k < 2; ++k) dst[n][k] = *(const PG8_LAS bf16x8*)(lds + PG8_SB(b, h) + boff + n * 2048 + k * 1024); } while (0)
#define PG8_MMA(ai, bj, At, Bt) do { __builtin_amdgcn_s_setprio(1); _Pragma("unroll") for (int m = 0; m < 4; ++m) _Pragma("unroll") for (int n = 0; n < 2; ++n) _Pragma("unroll") for (int k = 0; k < 2; ++k) \
        acc[ai][bj][m][n] = __builtin_amdgcn_mfma_f32_16x16x32_bf16(Bt[n][k], At[m][k], acc[ai][bj][m][n], 0, 0, 0); __builtin_amdgcn_s_setprio(0); } while (0)
#define PG8_WAIT_V(n) asm volatile("s_waitcnt vmcnt(" #n ")" ::: "memory")
#define PG8_WAIT_L(n) asm volatile("s_waitcnt lgkmcnt(" #n ")" ::: "memory")
#define PG8_BAR __builtin_amdgcn_s_barrier()
#define PG8_SCHED __builtin_amdgcn_sched_barrier(0)
    Unit cur, nxt; int ui = 0;
    if (!S.next(0, cur)) return;
    f32x4 acc[2][2][4][2];
#pragma unroll
    for (int a = 0; a < 2; ++a)
#pragma unroll
        for (int b = 0; b < 2; ++b)
#pragma unroll
            for (int m = 0; m < 4; ++m)
#pragma unroll
                for (int n = 0; n < 2; ++n) acc[a][b][m][n] = (f32x4){0.f, 0.f, 0.f, 0.f};
    bf16x8 At[4][2], B0[2][2], B1[2][2];
    const char* cA = (const char*)g.A + (size_t)cur.pm * tstep; const char* cB = (const char*)g.Bt + (size_t)cur.pn * tstep;
    S.a_ready(cur);
    if constexpr (SP2) {
        PG8_STAGE(PG8_SB(0, 0), cB, voffB); PG8_STAGE(PG8_SB(0, 1), cB + hstep, voffB); PG8_STAGE(PG8_SA(0, 0), cA, voffA); PG8_STAGE(PG8_SA(0, 1), cA + hstep, voffA);
        if (wr == 1) PG8_BAR;
        PG8_WAIT_V(2); PG8_BAR;
        PG8_STAGE(PG8_SB(1, 0), cB + kstep, voffB); PG8_STAGE(PG8_SA(1, 0), cA + kstep, voffA); PG8_STAGE(PG8_SB(1, 1), cB + hstep + kstep, voffB);
        PG8_WAIT_V(6); PG8_BAR;
    } else {
        PG8_STAGE(PG8_SB(0, 0), cB, voffB); PG8_STAGE(PG8_SA(0, 0), cA, voffA); PG8_STAGE(PG8_SB(0, 1), cB + hstep, voffB); PG8_STAGE(PG8_SA(0, 1), cA + hstep, voffA);
        if (wr == 1) PG8_BAR;
        PG8_WAIT_V(4); PG8_BAR;
        PG8_STAGE(PG8_SB(1, 0), cB + kstep, voffB); PG8_STAGE(PG8_SA(1, 0), cA + kstep, voffA); PG8_STAGE(PG8_SB(1, 1), cB + hstep + kstep, voffB);
        PG8_WAIT_V(6); PG8_BAR;
    }
    for (;;) {
        const bool has_next = S.next(ui + 1, nxt);
        const char* nA = has_next ? (const char*)g.A + (size_t)nxt.pm * tstep : cA; const char* nB = has_next ? (const char*)g.Bt + (size_t)nxt.pn * tstep : cB;
        for (int t = 0; t < nt; t += 2) {
            const bool last = (t == nt - 2);
            const char* a1 = cA + (size_t)(t + 1) * kstep;
            const char* a2 = last ? nA : cA + (size_t)(t + 2) * kstep; const char* b2 = last ? nB : cB + (size_t)(t + 2) * kstep;
            const char* a3 = a2 + kstep; const char* b3 = b2 + kstep;
            if (last && has_next) S.a_ready(nxt);
            if constexpr (SP2) {
            PG8_LDB(B0, 0, 0); PG8_LDB(B1, 0, 1); PG8_SCHED; PG8_LDA(At, 0, 0); PG8_STAGE(PG8_SA(1, 1), a1 + hstep, voffA);
            PG8_WAIT_V(8); PG8_WAIT_L(0); PG8_BAR; PG8_MMA(0, 0, At, B0); PG8_MMA(0, 1, At, B1); PG8_BAR; PG8_SCHED;
            PG8_LDA(At, 0, 1); PG8_STAGE(PG8_SB(0, 0), b2, voffB); PG8_STAGE(PG8_SB(0, 1), b2 + hstep, voffB); PG8_STAGE(PG8_SA(0, 0), a2, voffA);
            PG8_WAIT_V(8); PG8_WAIT_L(0); PG8_BAR; PG8_MMA(1, 0, At, B0); PG8_MMA(1, 1, At, B1); PG8_BAR; PG8_SCHED;
            PG8_LDB(B0, 1, 0); PG8_LDB(B1, 1, 1); PG8_SCHED; PG8_LDA(At, 1, 0); PG8_STAGE(PG8_SA(0, 1), a2 + hstep, voffA);
            PG8_WAIT_V(8); PG8_WAIT_L(0); PG8_BAR; PG8_MMA(0, 0, At, B0); PG8_MMA(0, 1, At, B1); PG8_BAR; PG8_SCHED;
            PG8_LDA(At, 1, 1); PG8_STAGE(PG8_SB(1, 0), b3, voffB); PG8_STAGE(PG8_SB(1, 1), b3 + hstep, voffB); PG8_STAGE(PG8_SA(1, 0), a3, voffA);
            PG8_WAIT_V(8); PG8_WAIT_L(0); PG8_BAR; PG8_MMA(1, 0, At, B0); PG8_MMA(1, 1, At, B1); PG8_BAR; PG8_SCHED;
            } else {
            PG8_LDB(B0, 0, 0); PG8_SCHED; PG8_LDA(At, 0, 0); PG8_STAGE(PG8_SA(1, 1), a1 + hstep, voffA);
            PG8_WAIT_L(8); PG8_BAR; PG8_WAIT_L(0); PG8_MMA(0, 0, At, B0); PG8_BAR; PG8_SCHED;
            PG8_LDB(B1, 0, 1); PG8_STAGE(PG8_SB(0, 0), b2, voffB);
            PG8_BAR; PG8_WAIT_L(0); PG8_MMA(0, 1, At, B1); PG8_BAR;
            PG8_LDA(At, 0, 1); PG8_STAGE(PG8_SA(0, 0), a2, voffA);
            PG8_BAR; PG8_WAIT_L(0); PG8_MMA(1, 0, At, B0); PG8_BAR; PG8_SCHED;
            PG8_STAGE(PG8_SB(0, 1), b2 + hstep, voffB);
            PG8_WAIT_V(6); PG8_BAR; PG8_MMA(1, 1, At, B1); PG8_BAR;
            PG8_LDB(B0, 1, 0); PG8_SCHED; PG8_LDA(At, 1, 0); PG8_STAGE(PG8_SA(0, 1), a2 + hstep, voffA);
            PG8_WAIT_L(8); PG8_BAR; PG8_WAIT_L(0); PG8_MMA(0, 0, At, B0); PG8_BAR; PG8_SCHED;
            PG8_LDB(B1, 1, 1); PG8_STAGE(PG8_SB(1, 0), b3, voffB);
            PG8_BAR; PG8_WAIT_L(0); PG8_MMA(0, 1, At, B1); PG8_BAR;
            PG8_LDA(At, 1, 1); PG8_STAGE(PG8_SA(1, 0), a3, voffA);
            PG8_BAR; PG8_WAIT_L(0); PG8_MMA(1, 0, At, B0); PG8_BAR; PG8_SCHED;
            PG8_STAGE(PG8_SB(1, 1), b3 + hstep, voffB);
            PG8_WAIT_V(6); PG8_BAR; PG8_MMA(1, 1, At, B1); PG8_BAR;
            }
        }
        if constexpr (ALIGN_EPI) { if (wr == 0) PG8_BAR; }
        if constexpr (!Epi::AFTER_DRAIN) { E(acc, cur, wr, wc, fr, fq); S.done(cur); }
        if (!has_next) break;
#pragma unroll
        for (int a = 0; a < 2; ++a)
#pragma unroll
            for (int b = 0; b < 2; ++b)
#pragma unroll
                for (int m = 0; m < 4; ++m)
#pragma unroll
                    for (int n = 0; n < 2; ++n) acc[a][b][m][n] = (f32x4){0.f, 0.f, 0.f, 0.f};
        cur = nxt; cA = nA; cB = nB; ++ui;
        if constexpr (ALIGN_EPI) { if (wr == 1) PG8_BAR; }
    }
    PG8_WAIT_V(0);
    if constexpr (!ALIGN_EPI) { if (wr == 0) PG8_BAR; }
    PG8_BAR;
    if constexpr (Epi::AFTER_DRAIN) { E.fused(acc, cur, wr, wc, fr, fq, lds, wid, lane); S.done(cur); }
#undef PG8_SA
#undef PG8_SB
#undef PG8_STAGE
#undef PG8_LDA
#undef PG8_LDB
#undef PG8_MMA
#undef PG8_WAIT_V
#undef PG8_WAIT_L
#undef PG8_BAR
#undef PG8_SCHED
}
}
#define LAS __attribute__((address_space(3)))

#define XB_TMO      128
#define XB_XCNT(j)  (256  + 64 * (j))
#define XB_XSUB(j)  (1280 + 64 * (j))
#define XB_XGEN(j)  (2304 + 64 * (j))
#define XB_TOP      3328
#define XB_TOPGEN   3392
#define XCD_BAR_WORDS 3456
#define XB_SPIN_CAP (1u << 18)

__device__ __forceinline__ unsigned xb_ld(unsigned* p)              { return __hip_atomic_load(p, __ATOMIC_RELAXED, __HIP_MEMORY_SCOPE_AGENT); }
__device__ __forceinline__ unsigned xb_add(unsigned* p, unsigned v) { return __hip_atomic_fetch_add(p, v, __ATOMIC_RELAXED, __HIP_MEMORY_SCOPE_AGENT); }
__device__ __forceinline__ unsigned xb_xcc_id() { return (unsigned)__builtin_amdgcn_s_getreg((3 << 11) | 20) & 0xFu; }
#define XB_SPIN(cond, bar) do { unsigned _sp = 0; while (cond) { __builtin_amdgcn_s_sleep(1); \
    if ((++_sp & 255u) == 0u) { if (xb_ld(&(bar)[XB_TMO])) break; if (_sp > XB_SPIN_CAP) { atomicAdd(&(bar)[XB_TMO], 1u); break; } } } } while (0)

struct XcdBarrier {
    unsigned* bar; unsigned x;
    volatile LAS unsigned* st;
};

__device__ __forceinline__ XcdBarrier xcd_barrier_post(unsigned* bar, volatile LAS unsigned* st) {
    XcdBarrier b; b.bar = bar; b.x = xb_xcc_id(); b.st = st;
    if (threadIdx.x == 0) (void)xb_add(&bar[XB_XCNT(b.x)], 1u);
    return b;
}
__device__ __forceinline__ void xcd_barrier_complete(unsigned* bar, unsigned x, unsigned& nloc, unsigned& nx) {
    const unsigned G = gridDim.x * gridDim.y * gridDim.z;
    unsigned sum, cnt, mine, sp = 0u;
    for (;;) {
        sum = 0u; cnt = 0u; mine = 0u;
#pragma unroll
        for (unsigned j = 0; j < 16; ++j) { const unsigned c = xb_ld(&bar[XB_XCNT(j)]); sum += c; cnt += (c > 0u) ? 1u : 0u; mine = (j == x) ? c : mine; }
        if (sum == G) break;
        __builtin_amdgcn_s_sleep(1);
        if ((++sp & 255u) == 0u) { if (xb_ld(&bar[XB_TMO])) break; if (sp > XB_SPIN_CAP) { atomicAdd(&bar[XB_TMO], 1u); break; } }
    }
    nloc = mine > 0u ? mine : 1u; nx = cnt > 0u ? cnt : 1u;
}

__device__ __forceinline__ void xcd_barrier(const XcdBarrier& b) {
    asm volatile("s_waitcnt vmcnt(0)" ::: "memory");
    __syncthreads();
    if (threadIdx.x == 0) {
        unsigned* bar = b.bar;
        __builtin_amdgcn_s_waitcnt(0);
        unsigned nloc = b.st[0], nx = b.st[1];
        if (nloc == 0u) { xcd_barrier_complete(bar, b.x, nloc, nx); b.st[0] = nloc; b.st[1] = nx; }
        const unsigned old = xb_add(&bar[XB_XSUB(b.x)], 1u);
        const unsigned gen = old / nloc;
        if (old + 1u == (gen + 1u) * nloc) {
            __builtin_amdgcn_fence(__ATOMIC_RELEASE, "agent");
            asm volatile("s_waitcnt vmcnt(0)" ::: "memory");
            const unsigned og = xb_add(&bar[XB_TOP], 1u);
            const unsigned tg = og / nx;
            if (og + 1u == (tg + 1u) * nx) xb_add(&bar[XB_TOPGEN], 1u);
            else XB_SPIN(xb_ld(&bar[XB_TOPGEN]) == tg, bar);
            __builtin_amdgcn_fence(__ATOMIC_ACQUIRE, "agent");
            xb_add(&bar[XB_XGEN(b.x)], 1u);
            asm volatile("s_waitcnt vmcnt(0)" ::: "memory");
        } else {
            XB_SPIN(xb_ld(&bar[XB_XGEN(b.x)]) == gen, bar);
            __builtin_amdgcn_fence(__ATOMIC_ACQUIRE, "agent");
            asm volatile("s_waitcnt vmcnt(0)" ::: "memory");
        }
    }
    __syncthreads();
}


#define DI __device__ __forceinline__
#define LAS __attribute__((address_space(3)))
typedef unsigned short bf16_t;
typedef short bf16x8 __attribute__((ext_vector_type(8)));
typedef short s16x4 __attribute__((ext_vector_type(4)));
typedef float f32x4 __attribute__((ext_vector_type(4)));
typedef float f32x16 __attribute__((ext_vector_type(16)));
typedef unsigned u32x4 __attribute__((ext_vector_type(4)));
typedef unsigned u32x2 __attribute__((ext_vector_type(2)));
typedef LAS unsigned char* ldsp;

constexpr int D = 1024, NB = 4, SEQ = 8192, DEPTH = 4, M = NB * SEQ;
constexpr int DIN = 3344, ZLD = 3584, FF = 4096;
constexpr int C_U = 0, C_CB = 256, C_CC = 512, C_DQ = 768, C_DK = 1280, C_DV = 1792, C_GQ = 2304, C_GK = 2560, C_GV = 2816, C_GG = 3072, C_GA = 3328;
constexpr float EPS = 1e-6f;
constexpr float LOG2E = 1.4426950408889634f;

constexpr size_t LW_IN = (size_t)ZLD * D * 2, LW_OUT = (size_t)D * D * 2, LW_1 = (size_t)FF * D * 2, LW_2 = (size_t)D * FF * 2;
constexpr size_t LW = LW_IN + LW_OUT + LW_1 + LW_2;
constexpr size_t WS_WT = 0;
constexpr size_t WS_XB = WS_WT + DEPTH * LW;
constexpr size_t WS_VT = WS_XB;
constexpr size_t WS_ST = WS_XB + (size_t)32 * 1024 * 1024;
constexpr size_t WS_Z = WS_XB + (size_t)M * D * 2;
constexpr size_t WS_Y = WS_Z + (size_t)M * ZLD * 2;
constexpr size_t WS_SSQ1 = WS_Y + (size_t)M * D * 2;
constexpr size_t WS_SSQ2 = WS_SSQ1 + (size_t)M * 16 * 4;
constexpr size_t WS_DEC = WS_SSQ2 + (size_t)M * 16 * 4;
constexpr size_t WS_CTR = WS_DEC + (size_t)16 * 128 * 64 * 4;
constexpr size_t WS_BAR = WS_CTR + 16384;
constexpr size_t WS_END = WS_BAR + 16384;
static_assert(WS_Z + (size_t)M * FF * 2 <= WS_SSQ1, "h overlays z and y only");
static_assert(WS_END <= (size_t)512 * 1024 * 1024, "workspace");
constexpr int LDS_PHASE = 131072, LDS_BYTES = LDS_PHASE + 64;
DI float bflo(unsigned v) { return __uint_as_float(v << 16); }
DI float bfhi(unsigned v) { return __uint_as_float(v & 0xffff0000u); }
DI float bf1(bf16_t v) { return __uint_as_float((unsigned)v << 16); }
DI unsigned pk(float lo, float hi) { return pg8::cvt_pk_bf16(lo, hi); }
DI bf16_t f2bf(float f) { return (bf16_t)(pk(f, 0.f) & 0xffffu); }
#define LDS_WAIT() asm volatile("s_waitcnt lgkmcnt(0)" ::: "memory")

struct EpiScale {
    static constexpr bool PERM = true, AFTER_DRAIN = false;
    bf16_t* O; int ldc; const float* ssq; int act;
    DI void operator()(const f32x4 (&acc)[2][2][4][2], const pg8::Unit& u, int wr, int wc, int fr, int fq) const {
        const int row0 = u.pm * 256 + wr * 64 + fr, col0 = u.pn * 256 + wc * 32 + 8 * fq;
        f32x4 pp[8];
#pragma unroll
        for (int g = 0; g < 8; ++g) pp[g] = *(const f32x4*)(ssq + (size_t)(row0 + (g >> 2) * 128 + (g & 3) * 16) * 16 + 4 * fq);
#pragma unroll
        for (int ai = 0; ai < 2; ++ai)
#pragma unroll
            for (int m = 0; m < 4; ++m) {
                const int row = row0 + ai * 128 + m * 16;
                const f32x4 p = pp[ai * 4 + m];
                float s = (p[0] + p[1]) + (p[2] + p[3]);
                s += __shfl_xor(s, 16); s += __shfl_xor(s, 32);
                const float rstd = rsqrtf(s * (1.0f / D) + EPS);
                bf16_t* rowp = O + (size_t)row * ldc + col0;
#pragma unroll
                for (int bj = 0; bj < 2; ++bj) {
                    f32x4 v0 = acc[ai][bj][m][0] * rstd, v1 = acc[ai][bj][m][1] * rstd;
                    if (act) {
#pragma unroll
                        for (int k = 0; k < 4; ++k) { float a = fmaxf(v0[k], 0.f), b = fmaxf(v1[k], 0.f); v0[k] = a * a; v1[k] = b * b; }
                    }
                    u32x4 w; w.x = pk(v0[0], v0[1]); w.y = pk(v0[2], v0[3]); w.z = pk(v1[0], v1[1]); w.w = pk(v1[2], v1[3]);
                    *(u32x4*)(rowp + bj * 128) = w;
                }
            }
    }
};
struct EpiRes {
    static constexpr bool PERM = true, AFTER_DRAIN = false;
    const float* Xin; float* X; bf16_t* XB; float* ssq_out; float scale; int mid;
    DI void operator()(const f32x4 (&acc)[2][2][4][2], const pg8::Unit& u, int wr, int wc, int fr, int fq) const {
        const int row0 = u.pm * 256 + wr * 64 + fr, col0 = u.pn * 256 + wc * 32 + 8 * fq;
#pragma unroll
        for (int ai = 0; ai < 2; ++ai)
#pragma unroll
            for (int m = 0; m < 4; ++m) {
                const int row = row0 + ai * 128 + m * 16;
                float sq = 0.f;
#pragma unroll
                for (int bj = 0; bj < 2; ++bj) {
                    const size_t off = (size_t)row * D + col0 + bj * 128;
                    f32x4 a, b;
                    if (mid) { a = *(const f32x4*)(Xin + off); b = *(const f32x4*)(Xin + off + 4); }
                    else { const u32x4 h = *(const u32x4*)(XB + off); a = (f32x4){bflo(h.x), bfhi(h.x), bflo(h.y), bfhi(h.y)}; b = (f32x4){bflo(h.z), bfhi(h.z), bflo(h.w), bfhi(h.w)}; }
                    a += acc[ai][bj][m][0] * scale; b += acc[ai][bj][m][1] * scale;
                    if (!mid) { *(f32x4*)(X + off) = a; *(f32x4*)(X + off + 4) = b; }
                    sq += (a[0] * a[0] + a[1] * a[1]) + (a[2] * a[2] + a[3] * a[3]) + (b[0] * b[0] + b[1] * b[1]) + (b[2] * b[2] + b[3] * b[3]);
                    u32x4 w; w.x = pk(a[0], a[1]); w.y = pk(a[2], a[3]); w.z = pk(b[0], b[1]); w.w = pk(b[2], b[3]);
                    *(u32x4*)(XB + off) = w;
                }
                sq += __shfl_xor(sq, 16); sq += __shfl_xor(sq, 32);
                if (fq == 0) ssq_out[(size_t)row * 16 + u.pn * 4 + wc] = sq;
            }
    }
};

DI void transpose_item(const float* __restrict__ W, int K, int N, int NP, const float* __restrict__ g, bf16_t* WT, LAS float* scr, int item, int lane) {
    const int nblk = NP / 32, kb = item / nblk, nb = item % nblk, k0 = 64 * kb, n0 = 32 * nb;
    const int n = n0 + (lane & 31);
#pragma unroll
    for (int i = 0; i < 32; ++i) {
        const int kk = 2 * i + (lane >> 5);
        float v = (n < N) ? __builtin_nontemporal_load(W + (size_t)(k0 + kk) * N + n) : 0.f;
        if (g) v *= g[k0 + kk];
        scr[kk * 33 + (lane & 31)] = v;
    }
    LDS_WAIT();
    const int c = lane & 7;
#pragma unroll
    for (int j = 0; j < 4; ++j) {
        const int nn = (lane >> 3) + 8 * j; const LAS float* s = scr + (8 * c) * 33 + nn;
        u32x4 o; o.x = pk(s[0 * 33], s[1 * 33]); o.y = pk(s[2 * 33], s[3 * 33]); o.z = pk(s[4 * 33], s[5 * 33]); o.w = pk(s[6 * 33], s[7 * 33]);
        *(u32x4*)(WT + (size_t)(n0 + nn) * K + k0 + 8 * c) = o;
    }
    LDS_WAIT();
}

struct Args {
    const float* x; const float* ln1_g; const float* w_in; const float* conv_w; const float* q_norm_g; const float* k_norm_g; const float* diff_lambda;
    const float* diff_subln_g; const float* gla_alpha_w; const float* gla_alpha_b; const float* gla_norm_g; const float* w_out; const float* ln2_g;
    const float* w_mlp1; const float* w_mlp2; float* out; unsigned char* ws;
};

DI void prologue(const Args& a, ldsp lds, int tid, int G, int bid) {
    const int lane = tid & 63, wave = tid >> 6;
    LAS float* scr = (LAS float*)(lds + wave * 16384);
    const int gw = bid * 8 + wave, NGW = G * 8;
    constexpr int I_IN = (D / 64) * (ZLD / 32), I_OUT = (D / 64) * (D / 32), I_1 = (D / 64) * (FF / 32), I_2 = (FF / 64) * (D / 32);
    constexpr int I_L = I_IN + I_OUT + I_1 + I_2;
    for (int it = gw; it < DEPTH * I_L; it += NGW) {
        const int l = it / I_L; int r = it % I_L;
        bf16_t* wt = (bf16_t*)(a.ws + WS_WT + (size_t)l * LW);
        if (r < I_IN) { transpose_item(a.w_in + (size_t)l * D * DIN, D, DIN, ZLD, a.ln1_g + l * D, wt, scr, r, lane); continue; } r -= I_IN;
        wt += LW_IN / 2;
        if (r < I_OUT) { transpose_item(a.w_out + (size_t)l * D * D, D, D, D, nullptr, wt, scr, r, lane); continue; } r -= I_OUT;
        wt += LW_OUT / 2;
        if (r < I_1) { transpose_item(a.w_mlp1 + (size_t)l * D * FF, D, FF, FF, a.ln2_g + l * D, wt, scr, r, lane); continue; } r -= I_1;
        wt += LW_1 / 2;
        transpose_item(a.w_mlp2 + (size_t)l * FF * D, FF, D, D, nullptr, wt, scr, r, lane);
    }
    bf16_t* XB = (bf16_t*)(a.ws + WS_XB); float* ssq1 = (float*)(a.ws + WS_SSQ1);
    if (bid == 0 && tid < DEPTH * 16) ((unsigned*)(a.ws + WS_CTR))[tid * 64] = 0u;
    for (int m = gw; m < M; m += NGW) {
        const f32x4* xr = (const f32x4*)(a.x + (size_t)m * D) + lane;
        u32x2* xb = (u32x2*)(XB + (size_t)m * D) + lane;
        float s = 0.f;
#pragma unroll
        for (int j = 0; j < 4; ++j) {
            const f32x4 v = xr[64 * j]; s += (v[0] * v[0] + v[1] * v[1]) + (v[2] * v[2] + v[3] * v[3]);
            u32x2 o; o.x = pk(v[0], v[1]); o.y = pk(v[2], v[3]); xb[64 * j] = o;
        }
#pragma unroll
        for (int o = 1; o < 64; o <<= 1) s += __shfl_xor(s, o);
        if (lane < 16) ssq1[(size_t)m * 16 + lane] = lane == 0 ? s : 0.f;
    }
}

DI void unpack8(const u32x4 v, float (&f)[8]) {
    f[0] = bflo(v.x); f[1] = bfhi(v.x); f[2] = bflo(v.y); f[3] = bfhi(v.y); f[4] = bflo(v.z); f[5] = bfhi(v.z); f[6] = bflo(v.w); f[7] = bfhi(v.w);
}
DI u32x4 pack8(const float (&f)[8]) { u32x4 o; o.x = pk(f[0], f[1]); o.y = pk(f[2], f[3]); o.z = pk(f[4], f[5]); o.w = pk(f[6], f[7]); return o; }

DI void qk_norm(bf16_t* z, const float* qg, const float* kg, int tid, int G, int bid) {
    const int sub = tid & 127, vec = sub >> 3, l8 = sub & 7;
    const float* g = (vec < 8 ? qg : kg) + l8 * 8;
    float gv[8];
#pragma unroll
    for (int j = 0; j < 8; ++j) gv[j] = g[j] * (vec < 8 ? LOG2E * 0.125f : 1.0f);
    for (int it = bid; it < M / 32; it += G) {
        u32x4* p[8]; u32x4 v[8];
#pragma unroll
        for (int k = 0; k < 8; ++k) { p[k] = (u32x4*)(z + (size_t)(it * 32 + k * 4 + (tid >> 7)) * ZLD + C_DQ + vec * 64 + l8 * 8); v[k] = *p[k]; }
#pragma unroll
        for (int k = 0; k < 8; ++k) {
            float f[8]; unpack8(v[k], f);
            float ss = 0.f;
#pragma unroll
            for (int j = 0; j < 8; ++j) ss += f[j] * f[j];
            ss += __shfl_xor(ss, 1); ss += __shfl_xor(ss, 2); ss += __shfl_xor(ss, 4);
            const float r = rsqrtf(ss * (1.0f / 64.0f) + EPS);
#pragma unroll
            for (int j = 0; j < 8; ++j) f[j] = f[j] * r * gv[j];
            *p[k] = pack8(f);
        }
    }
}

DI void v_transpose(const bf16_t* z, bf16_t* VT, ldsp lds, int tid, int G, int bid) {
    for (int u = bid; u < 2048; u += G) {
        const int b = u >> 9, h = (u >> 7) & 3, tile = u & 127;
        __syncthreads();
#pragma unroll
        for (int i = 0; i < 2; ++i) {
            const int p = tid + 512 * i, tok = p >> 4, c16 = p & 15;
            const u32x4 v = *(const u32x4*)(z + (size_t)(b * SEQ + tile * 64 + tok) * ZLD + C_DV + h * 128 + c16 * 8);
            *(LAS u32x4*)(lds + tok * 272 + c16 * 16) = v;
        }
        __syncthreads();
        const int e = tid & 127, tg = tid >> 7, mg = tg >> 1, h2 = tg & 1;
        unsigned lo[8], hi[8];
#pragma unroll
        for (int k = 0; k < 8; ++k) {
            lo[k] = *(LAS bf16_t*)(lds + (32 * mg + 8 * h2 + k) * 272 + e * 2);
            hi[k] = *(LAS bf16_t*)(lds + (32 * mg + 16 + 8 * h2 + k) * 272 + e * 2);
        }
        u32x4* dst = (u32x4*)(VT + (size_t)((b * 4 + h) * 128 + e) * SEQ + tile * 64 + 32 * mg + 16 * h2);
        u32x4 o0, o1;
        o0.x = lo[0] | (lo[1] << 16); o0.y = lo[2] | (lo[3] << 16); o0.z = hi[0] | (hi[1] << 16); o0.w = hi[2] | (hi[3] << 16);
        o1.x = lo[4] | (lo[5] << 16); o1.y = lo[6] | (lo[7] << 16); o1.z = hi[4] | (hi[5] << 16); o1.w = hi[6] | (hi[7] << 16);
        dst[0] = o0; dst[1] = o1;
    }
}

DI void conv_phase(const bf16_t* z, bf16_t* Y, const float* cw, int tid, int G, int bid) {
    for (int idx = bid * 512 + tid; idx < M * 32; idx += G * 512) {
        const int tok = idx >> 5, cg8 = idx & 31, t = tok & (SEQ - 1);
        const bf16_t* zp = z + (size_t)tok * ZLD + cg8 * 8;
        float u0[8], c0[8], u1[8], c1[8], u2[8], c2[8], cb[8];
        unpack8(*(const u32x4*)(zp + C_U), u0); unpack8(*(const u32x4*)(zp + C_CC), c0); unpack8(*(const u32x4*)(zp + C_CB), cb);
        const bool h1 = t >= 1, h2 = t >= 2;
        const u32x4 zero = {0u, 0u, 0u, 0u};
        unpack8(h1 ? *(const u32x4*)(zp - ZLD + C_U) : zero, u1); unpack8(h1 ? *(const u32x4*)(zp - ZLD + C_CC) : zero, c1);
        unpack8(h2 ? *(const u32x4*)(zp - 2 * ZLD + C_U) : zero, u2); unpack8(h2 ? *(const u32x4*)(zp - 2 * ZLD + C_CC) : zero, c2);
        float o[8];
#pragma unroll
        for (int j = 0; j < 8; ++j) {
            const int c = cg8 * 8 + j;
            o[j] = cb[j] * (cw[2 * 256 + c] * (c0[j] * u0[j]) + cw[256 + c] * (c1[j] * u1[j]) + cw[c] * (c2[j] * u2[j]));
        }
        *(u32x4*)(Y + (size_t)tok * D + cg8 * 8) = pack8(o);
    }
}

#define MFMA16(a, b, c) __builtin_amdgcn_mfma_f32_16x16x32_bf16((a), (b), (c), 0, 0, 0)
#define MFMA32(a, b, c) __builtin_amdgcn_mfma_f32_32x32x16_bf16((a), (b), (c), 0, 0, 0)

DI void gla_scan(float* ST, const float* DEC, int tid, int G, int bid) {
    for (int u = bid; u < 128; u += G) {
        const int p = u >> 3, el = (u & 7) * 512 + tid, d = el & 63;
        float* st = ST + (size_t)p * 128 * 4096 + el; const float* dc = DEC + (size_t)p * 128 * 64 + d;
        float* so = st;
        float s = 0.f;
        for (int c0 = 0; c0 < 128; c0 += 32) {
            float kv[32], de[32];
#pragma unroll
            for (int i = 0; i < 32; ++i) { kv[i] = st[(size_t)(c0 + i) * 4096]; de[i] = dc[(c0 + i) * 64]; }
#pragma unroll
            for (int i = 0; i < 32; ++i) { so[(size_t)(c0 + i) * 4096] = s; s = de[i] * s + kv[i]; }
        }
    }
}

constexpr int G4_HEAD = 27648, G4_R1 = 9216, G4_R2 = 18432, G4_ALR = 110592, G4_TOT = 114688;
DI float log_sigmoid_fast(float x) { return fminf(x, 0.f) - __logf(1.0f + __expf(-fabsf(x))); }

template <int MODE>
DI void gla4_unit(const bf16_t* z, float* ST, float* DEC, bf16_t* Y, const float* aw_g, const float* ab_g, const float* ng, ldsp lds, int tid, int u) {
    const int b = u >> 7, c = u & 127, tok0 = b * SEQ + c * 64;
    const int hd = tid >> 7, d = tid & 63, half = (tid >> 6) & 1, lane = tid & 63, fr = lane & 15, fq = lane >> 4;
    const int p = b * 4 + hd;
    const ldsp hr = lds + hd * G4_HEAD;
    LAS float* alr = (LAS float*)(lds + G4_ALR); LAS float* tot = (LAS float*)(lds + G4_TOT);
    __syncthreads();
    {
        constexpr int NM = MODE ? 3 : 2;
#pragma unroll
        for (int i = 0; i < NM * 4; ++i) {
            const int pi = tid + 512 * i, mh = pi >> 9, mat = mh >> 2, head = mh & 3, row = (pi >> 3) & 63, pc = pi & 7;
            const int col = (MODE ? (mat == 0 ? C_GQ : (mat == 1 ? C_GK : C_GV)) : (mat == 0 ? C_GK : C_GV)) + head * 64 + pc * 8;
            const int reg = MODE ? mat * 9216 : (mat == 0 ? 0 : G4_R2);
            *(LAS u32x4*)(lds + head * G4_HEAD + reg + row * 144 + pc * 16) = *(const u32x4*)(z + (size_t)(tok0 + row) * ZLD + col);
        }
        const int idx = tid * 2, t = idx >> 4, r = idx & 15;
        const unsigned v = *(const unsigned*)(z + (size_t)(tok0 + t) * ZLD + C_GA + r);
        alr[t * 16 + r] = bflo(v); alr[t * 16 + r + 1] = bfhi(v);
    }
    float aw[16];
#pragma unroll
    for (int r = 0; r < 16; ++r) aw[r] = aw_g[r * 256 + hd * 64 + d];
    const float ab = ab_g[hd * 64 + d];
    __syncthreads();
    float bc[32];
    {
        float run = 0.f;
#pragma unroll
        for (int i = 0; i < 32; ++i) {
            const int t = 32 * half + i;
            float al = ab;
#pragma unroll
            for (int r = 0; r < 16; ++r) al += alr[t * 16 + r] * aw[r];
            run += log_sigmoid_fast(al) * (1.0f / 16.0f);
            bc[i] = run;
        }
        tot[half * 256 + hd * 64 + d] = run;
    }
    __syncthreads();
    const float t0 = tot[hd * 64 + d], t1 = tot[256 + hd * 64 + d];
    const float pre = half ? t0 : 0.f, blast = t0 + t1;
    if (MODE == 0) {
#pragma unroll
        for (int j = 0; j < 4; ++j) {
            float f[8];
#pragma unroll
            for (int k = 0; k < 8; ++k) { const int i = 8 * j + k; f[k] = bf1(*(LAS bf16_t*)(hr + (32 * half + i) * 144 + d * 2)) * __expf(blast - (bc[i] + pre)); }
            *(LAS u32x4*)(hr + G4_R1 + d * 144 + (32 * half + 8 * j) * 2) = pack8(f);
        }
        if (half == 0) DEC[(size_t)(p * 128 + c) * 64 + d] = __expf(blast);
        __syncthreads();
#pragma unroll
        for (int j = 0; j < 4; ++j) {
            unsigned w[4];
#pragma unroll
            for (int k = 0; k < 4; ++k) {
                const unsigned lo = *(LAS bf16_t*)(hr + G4_R2 + (32 * half + 8 * j + 2 * k) * 144 + d * 2), hi = *(LAS bf16_t*)(hr + G4_R2 + (32 * half + 8 * j + 2 * k + 1) * 144 + d * 2);
                w[k] = lo | (hi << 16);
            }
            u32x4 o; o.x = w[0]; o.y = w[1]; o.z = w[2]; o.w = w[3];
            *(LAS u32x4*)(hr + d * 144 + (32 * half + 8 * j) * 2) = o;
        }
        __syncthreads();
        f32x4 acc[2][4];
#pragma unroll
        for (int rt = 0; rt < 2; ++rt)
#pragma unroll
            for (int nt = 0; nt < 4; ++nt) acc[rt][nt] = (f32x4){0.f, 0.f, 0.f, 0.f};
#pragma unroll
        for (int ks = 0; ks < 2; ++ks) {
            bf16x8 af[2], bfm[4];
#pragma unroll
            for (int rt = 0; rt < 2; ++rt) af[rt] = *(LAS bf16x8*)(hr + G4_R1 + (32 * half + 16 * rt + fr) * 144 + (32 * ks + 8 * fq) * 2);
#pragma unroll
            for (int nt = 0; nt < 4; ++nt) bfm[nt] = *(LAS bf16x8*)(hr + (16 * nt + fr) * 144 + (32 * ks + 8 * fq) * 2);
#pragma unroll
            for (int rt = 0; rt < 2; ++rt)
#pragma unroll
                for (int nt = 0; nt < 4; ++nt) acc[rt][nt] = MFMA16(af[rt], bfm[nt], acc[rt][nt]);
        }
        float* st = ST + (size_t)(p * 128 + c) * 4096;
#pragma unroll
        for (int rt = 0; rt < 2; ++rt)
#pragma unroll
            for (int nt = 0; nt < 4; ++nt) *(f32x4*)(st + (16 * nt + fr) * 64 + 32 * half + 16 * rt + 4 * fq) = acc[rt][nt];
    } else {
#pragma unroll
        for (int i = 0; i < 32; ++i) {
            const float bb = bc[i] + pre;
            LAS bf16_t* qp = (LAS bf16_t*)(hr + (32 * half + i) * 144 + d * 2); LAS bf16_t* kp = (LAS bf16_t*)(hr + G4_R1 + (32 * half + i) * 144 + d * 2);
            *qp = f2bf(bf1(*qp) * 0.125f * __expf(bb)); *kp = f2bf(bf1(*kp) * __expf(-bb));
        }
        __syncthreads();
        f32x4 acc[2][4];
#pragma unroll
        for (int rt = 0; rt < 2; ++rt)
#pragma unroll
            for (int nt = 0; nt < 4; ++nt) acc[rt][nt] = (f32x4){0.f, 0.f, 0.f, 0.f};
#pragma unroll
        for (int ks = 0; ks < 2; ++ks) {
            bf16x8 af[2], bfm[4];
#pragma unroll
            for (int rt = 0; rt < 2; ++rt) af[rt] = *(LAS bf16x8*)(hr + (32 * half + 16 * rt + fr) * 144 + (32 * ks + 8 * fq) * 2);
#pragma unroll
            for (int nt = 0; nt < 4; ++nt) bfm[nt] = *(LAS bf16x8*)(hr + G4_R1 + (16 * nt + fr) * 144 + (32 * ks + 8 * fq) * 2);
#pragma unroll
            for (int rt = 0; rt < 2; ++rt)
#pragma unroll
                for (int nt = 0; nt < 4; ++nt) acc[rt][nt] = MFMA16(af[rt], bfm[nt], acc[rt][nt]);
        }
        unsigned vw[16];
#pragma unroll
        for (int k = 0; k < 16; ++k) {
            const unsigned lo = *(LAS bf16_t*)(hr + G4_R2 + (32 * half + 2 * k) * 144 + d * 2), hi = *(LAS bf16_t*)(hr + G4_R2 + (32 * half + 2 * k + 1) * 144 + d * 2);
            vw[k] = lo | (hi << 16);
        }
        __syncthreads();
#pragma unroll
        for (int rt = 0; rt < 2; ++rt)
#pragma unroll
            for (int nt = 0; nt < 4; ++nt)
#pragma unroll
                for (int r = 0; r < 4; ++r) {
                    const int t = 32 * half + 16 * rt + 4 * fq + r, sx = 16 * nt + fr;
                    *(LAS bf16_t*)(hr + G4_R1 + t * 144 + sx * 2) = f2bf(sx <= t ? acc[rt][nt][r] : 0.f);
                }
#pragma unroll
        for (int j = 0; j < 4; ++j) { u32x4 o; o.x = vw[4 * j]; o.y = vw[4 * j + 1]; o.z = vw[4 * j + 2]; o.w = vw[4 * j + 3]; *(LAS u32x4*)(hr + G4_R2 + d * 144 + (32 * half + 8 * j) * 2) = o; }
        __syncthreads();
#pragma unroll
        for (int rt = 0; rt < 2; ++rt)
#pragma unroll
            for (int nt = 0; nt < 4; ++nt) acc[rt][nt] = (f32x4){0.f, 0.f, 0.f, 0.f};
        const float* sp = ST + (size_t)(p * 128 + c) * 4096;
#pragma unroll
        for (int ks = 0; ks < 4; ++ks) {
            bf16x8 af[2], bfm[4];
            const int kk = (ks & 1) * 32 + 8 * fq;
#pragma unroll
            for (int rt = 0; rt < 2; ++rt) af[rt] = *(LAS bf16x8*)(hr + (ks < 2 ? G4_R1 : 0) + (32 * half + 16 * rt + fr) * 144 + kk * 2);
#pragma unroll
            for (int nt = 0; nt < 4; ++nt) {
                if (ks < 2) bfm[nt] = *(LAS bf16x8*)(hr + G4_R2 + (16 * nt + fr) * 144 + kk * 2);
                else { const f32x4 s0 = *(const f32x4*)(sp + (16 * nt + fr) * 64 + kk), s1 = *(const f32x4*)(sp + (16 * nt + fr) * 64 + kk + 4);
                       u32x4 o; o.x = pk(s0[0], s0[1]); o.y = pk(s0[2], s0[3]); o.z = pk(s1[0], s1[1]); o.w = pk(s1[2], s1[3]); bfm[nt] = __builtin_bit_cast(bf16x8, o); }
            }
#pragma unroll
            for (int rt = 0; rt < 2; ++rt)
#pragma unroll
                for (int nt = 0; nt < 4; ++nt) acc[rt][nt] = MFMA16(af[rt], bfm[nt], acc[rt][nt]);
        }
        __syncthreads();
#pragma unroll
        for (int rt = 0; rt < 2; ++rt)
#pragma unroll
            for (int nt = 0; nt < 4; ++nt)
#pragma unroll
                for (int r = 0; r < 4; ++r) *(LAS float*)(hr + (32 * half + 16 * rt + 4 * fq + r) * 272 + (16 * nt + fr) * 4) = acc[rt][nt][r];
        __syncthreads();
        {
            const int t7 = tid & 127, t = t7 >> 1, e0 = (t7 & 1) * 32;
            f32x4 o[8]; float ss = 0.f;
#pragma unroll
            for (int k = 0; k < 8; ++k) { o[k] = *(LAS f32x4*)(hr + t * 272 + (e0 + 4 * k) * 4); ss += (o[k][0] * o[k][0] + o[k][1] * o[k][1]) + (o[k][2] * o[k][2] + o[k][3] * o[k][3]); }
            ss += __shfl_xor(ss, 1);
            const float rs = rsqrtf(ss * (1.0f / 64.0f) + EPS);
#pragma unroll
            for (int k = 0; k < 4; ++k) {
                float gg[8]; unpack8(*(const u32x4*)(z + (size_t)(tok0 + t) * ZLD + C_GG + hd * 64 + e0 + 8 * k), gg);
                float ov[8];
#pragma unroll
                for (int j = 0; j < 8; ++j) {
                    const float x = j < 4 ? o[2 * k][j & 3] : o[2 * k + 1][j & 3];
                    ov[j] = x * rs * ng[e0 + 8 * k + j] * (gg[j] / (1.0f + __expf(-gg[j])));
                }
                *(u32x4*)(Y + (size_t)(tok0 + t) * D + 768 + hd * 64 + e0 + 8 * k) = pack8(ov);
            }
        }
    }
}

constexpr int AT_KT = 64 * 256, AT_VT = 128 * 128, AT_STG = AT_KT + AT_VT;
DI int crow16(int i) { return (i & 3) + 8 * (i >> 2); }

DI void attn_unit(const bf16_t* z, const bf16_t* VT, bf16_t* Y, const float* subg, ldsp lds, int tid, int b, int h, int qb, float lam, float ns, float oscale, int win) {
    const int w = __builtin_amdgcn_readfirstlane(tid >> 6), lane = tid & 63, fr = lane & 15, fq = lane >> 4;
    const int comp = w & 1, g = w >> 1;
    const int q0 = qb * 128 + g * 32, nt = 2 * qb + 2, wlast = 2 * qb + (g >> 1);
    const int jstart = max(0, (qb * 128 - win) >> 6), wfirst = max(0, (q0 - win) >> 6);
    bf16x8 qf[2][2];
#pragma unroll
    for (int qt = 0; qt < 2; ++qt)
#pragma unroll
        for (int ks = 0; ks < 2; ++ks) qf[qt][ks] = *(const bf16x8*)(z + (size_t)(b * SEQ + q0 + 16 * qt + fr) * ZLD + C_DQ + h * 128 + comp * 64 + 32 * ks + 8 * fq);
    f32x4 O[8][2];
#pragma unroll
    for (int e = 0; e < 8; ++e)
#pragma unroll
        for (int qt = 0; qt < 2; ++qt) O[e][qt] = (f32x4){0.f, 0.f, 0.f, 0.f};
    float ls0 = 0.f, ls1 = 0.f;
    const float tq0 = (float)(q0 + fr), tq1 = tq0 + 16.0f;
    const int kr = 4 * w + (lane >> 4), vr = 8 * w + (lane >> 3);
    const bf16_t* kg = z + (size_t)(b * SEQ + kr) * ZLD + C_DK + h * 128 + (((lane & 15) ^ (kr & 15)) * 8);
    const bf16_t* vg = VT + (size_t)((b * 4 + h) * 128 + vr) * SEQ + (((lane & 7) ^ ((vr >> 1) & 7)) * 8);
#define AT_DMA(j, buf) do { const ldsp sb = lds + (buf) * AT_STG; \
        __builtin_amdgcn_global_load_lds((const unsigned*)(kg + (size_t)(64 * (j)) * ZLD), (LAS unsigned*)(sb + w * 1024), 16, 0, 0); \
        __builtin_amdgcn_global_load_lds((const unsigned*)(kg + (size_t)(64 * (j) + 32) * ZLD), (LAS unsigned*)(sb + 8192 + w * 1024), 16, 0, 0); \
        __builtin_amdgcn_global_load_lds((const unsigned*)(vg + 64 * (j)), (LAS unsigned*)(sb + AT_KT + w * 1024), 16, 0, 0); \
        __builtin_amdgcn_global_load_lds((const unsigned*)(vg + (size_t)64 * SEQ + 64 * (j)), (LAS unsigned*)(sb + AT_KT + 8192 + w * 1024), 16, 0, 0); } while (0)
    int koff[2], voff[2];
#pragma unroll
    for (int ks = 0; ks < 2; ++ks) koff[ks] = fr * 256 + (((comp * 8 + 4 * ks + fq) ^ fr) * 16);
#pragma unroll
    for (int m = 0; m < 2; ++m) voff[m] = AT_KT + fr * 128 + (((4 * m + fq) ^ ((fr >> 1) & 7)) * 16);
    __syncthreads();
    AT_DMA(jstart, jstart & 1);
    asm volatile("s_waitcnt vmcnt(0)" ::: "memory");
    __syncthreads();
    for (int j = jstart; j < nt; ++j) {
        if (j + 1 < nt) AT_DMA(j + 1, (j + 1) & 1);
        if (j <= wlast && j >= wfirst) {
            const ldsp sb = lds + (j & 1) * AT_STG;
            bf16x8 vf0[8], vf1[8];
            f32x4 S[4][2];
#pragma unroll
            for (int kt = 0; kt < 4; ++kt)
#pragma unroll
                for (int qt = 0; qt < 2; ++qt) S[kt][qt] = (f32x4){0.f, 0.f, 0.f, 0.f};
#pragma unroll
            for (int ks = 0; ks < 2; ++ks) {
                bf16x8 kf[4];
#pragma unroll
                for (int kt = 0; kt < 4; ++kt) kf[kt] = *(LAS bf16x8*)(sb + koff[ks] + kt * 4096);
#pragma unroll
                for (int kt = 0; kt < 4; ++kt)
#pragma unroll
                    for (int qt = 0; qt < 2; ++qt) S[kt][qt] = MFMA16(kf[kt], qf[qt][ks], S[kt][qt]);
            }
            const float dl0 = (float)(64 * j + 4 * fq) - tq0, dl1 = (float)(64 * j + 4 * fq) - tq1;
#define AT_EXP(m, qt, dl, dst, lsv) do { float p[8]; \
                _Pragma("unroll") for (int i = 0; i < 8; ++i) { const int kt = 2 * (m) + (i >> 2), r = i & 3; \
                    p[i] = __builtin_amdgcn_exp2f(fmaf(fabsf((dl) + (float)(16 * kt + r)), ns, S[kt][qt][r])); } \
                lsv += ((p[0] + p[1]) + (p[2] + p[3])) + ((p[4] + p[5]) + (p[6] + p[7])); \
                u32x4 u; u.x = pk(p[0], p[1]); u.y = pk(p[2], p[3]); u.z = pk(p[4], p[5]); u.w = pk(p[6], p[7]); dst = __builtin_bit_cast(bf16x8, u); } while (0)
            bf16x8 pf[2], pg[2];
#pragma unroll
            for (int et = 0; et < 8; ++et) vf0[et] = *(LAS bf16x8*)(sb + voff[0] + et * 2048);
            AT_EXP(0, 0, dl0, pf[0], ls0); AT_EXP(0, 1, dl1, pf[1], ls1);
#pragma unroll
            for (int et = 0; et < 8; ++et) vf1[et] = *(LAS bf16x8*)(sb + voff[1] + et * 2048);
            AT_EXP(1, 0, dl0, pg[0], ls0); AT_EXP(1, 1, dl1, pg[1], ls1);
            __builtin_amdgcn_sched_barrier(0);
#pragma unroll
            for (int et = 0; et < 8; ++et)
#pragma unroll
                for (int qt = 0; qt < 2; ++qt) O[et][qt] = MFMA16(vf0[et], pf[qt], O[et][qt]);
#pragma unroll
            for (int et = 0; et < 8; ++et)
#pragma unroll
                for (int qt = 0; qt < 2; ++qt) O[et][qt] = MFMA16(vf1[et], pg[qt], O[et][qt]);
#undef AT_EXP
        }
        asm volatile("s_waitcnt vmcnt(0)" ::: "memory");
        __syncthreads();
    }
#undef AT_DMA
    ls0 += __shfl_xor(ls0, 16); ls0 += __shfl_xor(ls0, 32);
    ls1 += __shfl_xor(ls1, 16); ls1 += __shfl_xor(ls1, 32);
    const float sc0 = comp ? lam / ls0 : 1.0f / ls0, sc1 = comp ? lam / ls1 : 1.0f / ls1;
    const ldsp xp = lds + g * 16384 + lane * 4;
    if (comp) {
#pragma unroll
        for (int e = 0; e < 8; ++e)
#pragma unroll
            for (int qt = 0; qt < 2; ++qt)
#pragma unroll
                for (int r = 0; r < 4; ++r) *(LAS float*)(xp + ((2 * e + qt) * 4 + r) * 256) = O[e][qt][r] * (qt ? sc1 : sc0);
    }
    __syncthreads();
    if (!comp) {
        float ss0 = 0.f, ss1 = 0.f;
#pragma unroll
        for (int e = 0; e < 8; ++e)
#pragma unroll
            for (int qt = 0; qt < 2; ++qt)
#pragma unroll
                for (int r = 0; r < 4; ++r) {
                    const float o = O[e][qt][r] * (qt ? sc1 : sc0) - *(LAS float*)(xp + ((2 * e + qt) * 4 + r) * 256);
                    O[e][qt][r] = o; if (qt) ss1 += o * o; else ss0 += o * o;
                }
        ss0 += __shfl_xor(ss0, 16); ss0 += __shfl_xor(ss0, 32);
        ss1 += __shfl_xor(ss1, 16); ss1 += __shfl_xor(ss1, 32);
        const float r0 = rsqrtf(ss0 * (1.0f / 128.0f) + EPS) * oscale, r1 = rsqrtf(ss1 * (1.0f / 128.0f) + EPS) * oscale;
#pragma unroll
        for (int qt = 0; qt < 2; ++qt) {
            bf16_t* yrow = Y + (size_t)(b * SEQ + q0 + 16 * qt + fr) * D + 256 + h * 128;
            const float rr = qt ? r1 : r0;
#pragma unroll
            for (int e = 0; e < 8; ++e) {
                const int e0 = 16 * e + 4 * fq;
                const f32x4 gn = *(const f32x4*)(subg + e0);
                u32x2 o; o.x = pk(O[e][qt][0] * rr * gn[0], O[e][qt][1] * rr * gn[1]); o.y = pk(O[e][qt][2] * rr * gn[2], O[e][qt][3] * rr * gn[3]);
                *(u32x2*)(yrow + e0) = o;
            }
        }
    }
}

__global__ void __launch_bounds__(512, 2) hybrid_fwd(Args a) {
    extern __shared__ __attribute__((aligned(16))) unsigned char lds_raw[];
    const ldsp lds = (ldsp)lds_raw;
    cg::grid_group grid = cg::this_grid();
    const int tid0 = threadIdx.x, G0 = gridDim.x, bid0 = blockIdx.x;
    unsigned char* ws = a.ws;
    bf16_t* XB = (bf16_t*)(ws + WS_XB); bf16_t* VT = (bf16_t*)(ws + WS_VT); float* ST = (float*)(ws + WS_ST);
    bf16_t* Z = (bf16_t*)(ws + WS_Z); bf16_t* H = (bf16_t*)(ws + WS_Z); bf16_t* Y = (bf16_t*)(ws + WS_Y);
    float* SSQ1 = (float*)(ws + WS_SSQ1); float* SSQ2 = (float*)(ws + WS_SSQ2); float* DEC = (float*)(ws + WS_DEC);

    if (tid0 < 16) *(LAS unsigned*)(lds + LDS_PHASE + 4 * tid0) = 0u;
    __syncthreads();
    const XcdBarrier xbar = xcd_barrier_post((unsigned*)(ws + WS_BAR), (volatile LAS unsigned*)(lds + LDS_PHASE));
    prologue(a, lds, tid0, G0, bid0);
    grid.sync();

    for (int step = 0; step < DEPTH * 7; ++step) {
        const int l = step / 7, ph = step % 7;
        int tid = tid0; asm volatile("" : "+v"(tid));
        int G = G0, bid = bid0; asm volatile("" : "+s"(G), "+s"(bid));
        const bf16_t* wt_in = (const bf16_t*)(ws + WS_WT + (size_t)l * LW);
        const bf16_t* wt_out = wt_in + LW_IN / 2; const bf16_t* wt_1 = wt_out + LW_OUT / 2; const bf16_t* wt_2 = wt_1 + LW_1 / 2;
        if (ph == 0 || ph == 5) {
            const bool up = ph == 5;
            pg8::Gemm g{XB, up ? wt_1 : wt_in, M, up ? FF : ZLD, D}; pg8::StaticOrder S; S.init(M, up ? FF : ZLD, G, bid);
            EpiScale E{up ? H : Z, up ? FF : ZLD, up ? SSQ2 : SSQ1, up ? 1 : 0};
            pg8::gemm_phase<EpiScale, pg8::StaticOrder, true, true>(lds, g, S, E);
        } else if (ph == 4 || ph == 6) {
            const bool dn = ph == 6;
            pg8::Gemm g{dn ? H : Y, dn ? wt_2 : wt_out, M, D, dn ? FF : D}; pg8::StaticOrder S; S.init(M, D, G, bid);
            EpiRes E{l == 0 ? a.x : a.out, a.out, XB, dn ? SSQ1 : SSQ2, 1.0f, dn ? 0 : 1};
            pg8::gemm_phase<EpiRes, pg8::StaticOrder, true, true>(lds, g, S, E);
        } else if (ph == 1) {
            qk_norm(Z, a.q_norm_g + l * 64, a.k_norm_g + l * 64, tid, G, bid);
            v_transpose(Z, VT, lds, tid, G, bid);
            conv_phase(Z, Y, a.conv_w + l * 3 * 256, tid, G, bid);
            for (int u = bid; u < 512; u += G) { int tu = tid; asm volatile("" : "+v"(tu)); gla4_unit<0>(Z, ST, DEC, Y, a.gla_alpha_w + (size_t)l * 16 * 256, a.gla_alpha_b + l * 256, a.gla_norm_g + l * 64, lds, tu, u); }
        } else if (ph == 2) {
            gla_scan(ST, DEC, tid, G, bid);
        } else {
            const float* lp = a.diff_lambda + l * 256;
            const int lane = tid & 63;
            float v1 = lp[lane] * lp[64 + lane], v2 = lp[128 + lane] * lp[192 + lane];
#pragma unroll
            for (int o = 1; o < 64; o <<= 1) { v1 += __shfl_xor(v1, o); v2 += __shfl_xor(v2, o); }
            const float lam_init = 0.8f - 0.6f * expf(-0.3f * (float)l);
            const float lam = expf(v1) - expf(v2) + lam_init;
            float gq = fabsf(a.q_norm_g[l * 64 + lane]), gk = fabsf(a.k_norm_g[l * 64 + lane]);
#pragma unroll
            for (int o = 1; o < 64; o <<= 1) { gq = fmaxf(gq, __shfl_xor(gq, o)); gk = fmaxf(gk, __shfl_xor(gk, o)); }
            const float smax = 8.0f * gq * gk * 1.01f;
            const int xcc = (int)(__builtin_amdgcn_s_getreg((3 << 11) | 20) & 7u);
            int it = 0;
            unsigned* ctr = (unsigned*)(ws + WS_CTR) + l * 512;
            unsigned live = 0xffu;
            for (int qi = 0; qi < 8; ++qi) {
                const int xq = (xcc + qi) & 7;
                if (qi == 1) {
                    const ldsp pm = lds + LDS_PHASE + 32;
                    if (tid < 64) {
                        const bool has = tid >= 1 && tid < 8 && __hip_atomic_load(ctr + ((xcc + tid) & 7) * 64, __ATOMIC_RELAXED, __HIP_MEMORY_SCOPE_AGENT) < 128u + 64u;
                        const unsigned long long m = __ballot(has);
                        if (tid == 0) *(LAS unsigned*)pm = (unsigned)m;
                    }
                    __syncthreads();
                    live = *(LAS unsigned*)pm;
                }
                if (!((live >> qi) & 1u)) continue;
                for (;; ++it) {
                    const ldsp slot = lds + LDS_PHASE + 16 + (it & 1) * 4;
                    if (tid == 0) *(LAS unsigned*)slot = __hip_atomic_fetch_add(ctr + xq * 64, 1u, __ATOMIC_RELAXED, __HIP_MEMORY_SCOPE_AGENT);
                    __syncthreads();
                    const int idx = (int)*(LAS unsigned*)slot;
                    if (idx >= 128 + 64) break;
                    int tu = tid; asm volatile("" : "+v"(tu));
                    if (idx < 128) {
                        const int r = 63 - (xq & 1) - 2 * (idx >> 2), h = idx & 3, b = xq >> 1;
                        const float slope = exp2f(-2.0f * (float)(h + 1));
                        const float wf = (104.0f + 2.0f * smax) / slope;
                        const int win = wf < 16384.0f ? (int)wf + 1 : 16384;
                        attn_unit(Z, VT, Y, a.diff_subln_g + l * 128, lds, tu, b, h, r, lam, -slope * LOG2E, 1.0f - lam_init, win);
                    } else {
                        gla4_unit<1>(Z, ST, DEC, Y, a.gla_alpha_w + (size_t)l * 16 * 256, a.gla_alpha_b + l * 256, a.gla_norm_g + l * 64, lds, tu, xq * 64 + idx - 128);
                    }
                }
                ++it;
            }
        }
        xcd_barrier(xbar);
    }
}

extern "C" void kernel_launch(void* const* d_in, const int* in_sizes, int n_in, void* d_out, int out_size, void* d_ws, size_t ws_size, hipStream_t stream) {
    static int grid_blocks = 0;
    if (grid_blocks == 0) {
        if (n_in != 15 || out_size != M * D || ws_size < WS_END) { fprintf(stderr, "kernel_launch: unexpected shapes (n_in %d out %d ws %zu)\n", n_in, out_size, ws_size); grid_blocks = -1; return; }
        int dev = 0, cus = 0, per_cu = 0;
        hipGetDevice(&dev);
        hipDeviceGetAttribute(&cus, hipDeviceAttributeMultiprocessorCount, dev);
        if (hipFuncSetAttribute((const void*)hybrid_fwd, hipFuncAttributeMaxDynamicSharedMemorySize, LDS_BYTES) != hipSuccess) { fprintf(stderr, "kernel_launch: hipFuncSetAttribute failed\n"); grid_blocks = -1; return; }
        if (hipOccupancyMaxActiveBlocksPerMultiprocessor(&per_cu, (const void*)hybrid_fwd, 512, LDS_BYTES) != hipSuccess || per_cu < 1) { fprintf(stderr, "kernel_launch: occupancy query gave %d\n", per_cu); per_cu = 1; }
        (void)hipGetLastError();
        grid_blocks = cus * 1;
        fprintf(stderr, "kernel_launch: cus %d per_cu %d grid %d\n", cus, per_cu, grid_blocks);
    }
    if (grid_blocks < 0) return;
    Args a{};
    a.x = (const float*)d_in[0]; a.ln1_g = (const float*)d_in[1]; a.w_in = (const float*)d_in[2]; a.conv_w = (const float*)d_in[3];
    a.q_norm_g = (const float*)d_in[4]; a.k_norm_g = (const float*)d_in[5]; a.diff_lambda = (const float*)d_in[6]; a.diff_subln_g = (const float*)d_in[7];
    a.gla_alpha_w = (const float*)d_in[8]; a.gla_alpha_b = (const float*)d_in[9]; a.gla_norm_g = (const float*)d_in[10]; a.w_out = (const float*)d_in[11];
    a.ln2_g = (const float*)d_in[12]; a.w_mlp1 = (const float*)d_in[13]; a.w_mlp2 = (const float*)d_in[14];
    a.out = (float*)d_out; a.ws = (unsigned char*)d_ws;
    if (hipMemsetAsync((char*)d_ws + WS_BAR, 0, 16384, stream) != hipSuccess) { fprintf(stderr, "kernel_launch: hipMemsetAsync failed\n"); return; }
    void* args[] = {&a};
    hipError_t e = hipLaunchCooperativeKernel((const void*)hybrid_fwd, dim3(grid_blocks), dim3(512), args, LDS_BYTES, stream);
    if (e != hipSuccess) fprintf(stderr, "kernel_launch: cooperative launch failed: %s (grid %d)\n", hipGetErrorString(e), grid_blocks);
}
```

```cpp
#include <hip/hip_runtime.h>
#include <hip/hip_cooperative_groups.h>
#include <cstdio>
#include <cstdint>
namespace cg = cooperative_groups;
namespace pg8 {
#define PG8_LAS __attribute__((address_space(3)))
typedef unsigned short bf16_t;
typedef short bf16x8 __attribute__((ext_vector_type(8)));
typedef float f32x4 __attribute__((ext_vector_type(4)));
typedef unsigned u32x4 __attribute__((ext_vector_type(4)));
constexpr int BM = 256, BK = 64, HALF = 128, HTB = HALF * BK * 2  , STAGE_BYTES = 8 * HTB, NXCD = 8, WGM = 8;

__host__ __device__ __forceinline__ int lds_byte(int r, int c) { const int st = (r >> 4) * 2 + (c >> 5), rr = r & 15, cc = c & 31, ob = rr * 64 + cc * 2; return st * 1024 + (ob ^ (((ob >> 9) & 1) << 5)); }
__host__ __device__ __forceinline__ void stage_rc(int b, int& R, int& C) { const int st = b / 1024, sb = b % 1024, swz = sb ^ (((sb >> 9) & 1) << 5); R = (st >> 1) * 16 + swz / 64; C = (st & 1) * 32 + (swz % 64) / 2; }
__host__ __device__ __forceinline__ int perm32(int rho) { const int n = rho >> 4, i = rho & 15; return 8 * (i >> 2) + 4 * n + (i & 3); }

struct Unit { int pm, pn; };
struct Gemm { const bf16_t* A; const bf16_t* Bt; int M, N, K; };

struct StaticOrder {
    int nM, nN, nwg, G, c;
    __host__ __device__ void init(int M, int N, int G_, int c_) { nM = M / BM; nN = N / BM; nwg = nM * nN; G = G_; c = c_; }
    __host__ __device__ bool next(int i, Unit& u) const {
        const long L = (long)i * G + c; if (L >= nwg) return false;
        int wgid = (int)L; { const int q = nwg / NXCD, r = nwg % NXCD, xcd = wgid % NXCD, off = wgid / NXCD; wgid = (xcd < r ? xcd * (q + 1) : r * (q + 1) + (xcd - r) * q) + off; }
        const int nig = WGM * nN, gid = wgid / nig, fm = gid * WGM, gsz = (nM - fm) < WGM ? (nM - fm) : WGM;
        u.pm = fm + ((wgid % nig) % gsz); u.pn = (wgid % nig) / gsz; return true;
    }
    __device__ __forceinline__ void a_ready(const Unit&) const {}
    __device__ __forceinline__ void done(const Unit&) const {}
};
__device__ __forceinline__ unsigned cvt_pk_bf16(float lo, float hi) { unsigned r; asm volatile("v_cvt_pk_bf16_f32 %0, %1, %2" : "=v"(r) : "v"(lo), "v"(hi)); return r; }
typedef float f32x2 __attribute__((ext_vector_type(2)));
template <class Epi, class Sched, bool ALIGN_EPI = false, bool SP2 = false>
__device__ __forceinline__ void gemm_phase(PG8_LAS unsigned char* lds, const Gemm g, const Sched& S, const Epi& E) {
    int tid = threadIdx.x; asm volatile("" : "+v"(tid));
    const int wid = __builtin_amdgcn_readfirstlane(tid >> 6), lane = tid & 63, wr = wid >> 2, wc = wid & 3, fr = lane & 15, fq = lane >> 4;
    const int K = g.K, nt = K / BK;
    unsigned voffA[2], voffB[2];
#pragma unroll
    for (int i = 0; i < 2; ++i) { int R, C; stage_rc(tid * 16 + i * 8192, R, C); const int Rb = Epi::PERM ? ((R & ~31) + perm32(R & 31)) : R;
        voffA[i] = (unsigned)(R * K + C) * 2u; voffB[i] = (unsigned)(Rb * K + C) * 2u; }
    const size_t kstep = (size_t)(BK * 2);
    const size_t hstep = (size_t)HALF * K * 2;
    const size_t tstep = 2 * hstep;
    const unsigned ldsw = (unsigned)wid * 1024u;
    const int aoff = lds_byte(wr * 64 + fr, fq * 8), boff = lds_byte(wc * 32 + fr, fq * 8);
#define PG8_SA(b, h) (((b) * 2 + (h)) * HTB)
#define PG8_SB(b, h) ((4 + (b) * 2 + (h)) * HTB)
#define PG8_STAGE(bufoff, gbase, voff) do { _Pragma("unroll") for (int _i = 0; _i < 2; ++_i) \
        __builtin_amdgcn_global_load_lds((const unsigned*)((const char*)(gbase) + (voff)[_i]), (PG8_LAS unsigned*)(lds + (bufoff) + ldsw + _i * 8192), 16, 0, 0); } while (0)
#define PG8_LDA(dst, b, h) do { _Pragma("unroll") for (int m = 0; m < 4; ++m) _Pragma("unroll") for (int k = 0; k < 2; ++k) dst[m][k] = *(const PG8_LAS bf16x8*)(lds + PG8_SA(b, h) + aoff + m * 2048 + k * 1024); } while (0)
#define PG8_LDB(dst, b, h) do { _Pragma("unroll") for (int n = 0; n < 2; ++n) _Pragma("unroll") for (int k = 0; k < 2; ++k) dst[n][k] = *(const PG8_LAS bf16x8*)(lds + PG8_SB(b, h) + boff + n * 2048 + k * 1024); } while (0)
#define PG8_MMA(ai, bj, At, Bt) do { __builtin_amdgcn_s_setprio(1); _Pragma("unroll") for (int m = 0; m < 4; ++m) _Pragma("unroll") for (int n = 0; n < 2; ++n) _Pragma("unroll") for (int k = 0; k < 2; ++k) \
        acc[ai][bj][m][n] = __builtin_amdgcn_mfma_f32_16x16x32_bf16(Bt[n][k], At[m][k], acc[ai][bj][m][n], 0, 0, 0); __builtin_amdgcn_s_setprio(0); } while (0)
#define PG8_WAIT_V(n) asm volatile("s_waitcnt vmcnt(" #n ")" ::: "memory")
#define PG8_WAIT_L(n) asm volatile("s_waitcnt lgkmcnt(" #n ")" ::: "memory")
#define PG8_BAR __builtin_amdgcn_s_barrier()
#define PG8_SCHED __builtin_amdgcn_sched_barrier(0)
    Unit cur, nxt; int ui = 0;
    if (!S.next(0, cur)) return;
    f32x4 acc[2][2][4][2];
#pragma unroll
    for (int a = 0; a < 2; ++a)
#pragma unroll
        for (int b = 0; b < 2; ++b)
#pragma unroll
            for (int m = 0; m < 4; ++m)
#pragma unroll
                for (int n = 0; n < 2; ++n) acc[a][b][m][n] = (f32x4){0.f, 0.f, 0.f, 0.f};
    bf16x8 At[4][2], B0[2][2], B1[2][2];
    const char* cA = (const char*)g.A + (size_t)cur.pm * tstep; const char* cB = (const char*)g.Bt + (size_t)cur.pn * tstep;
    S.a_ready(cur);
    if constexpr (SP2) {
        PG8_STAGE(PG8_SB(0, 0), cB, voffB); PG8_STAGE(PG8_SB(0, 1), cB + hstep, voffB); PG8_STAGE(PG8_SA(0, 0), cA, voffA); PG8_STAGE(PG8_SA(0, 1), cA + hstep, voffA);
        if (wr == 1) PG8_BAR;
        PG8_WAIT_V(2); PG8_BAR;
        PG8_STAGE(PG8_SB(1, 0), cB + kstep, voffB); PG8_STAGE(PG8_SA(1, 0), cA + kstep, voffA); PG8_STAGE(PG8_SB(1, 1), cB + hstep + kstep, voffB);
        PG8_WAIT_V(6); PG8_BAR;
    } else {
        PG8_STAGE(PG8_SB(0, 0), cB, voffB); PG8_STAGE(PG8_SA(0, 0), cA, voffA); PG8_STAGE(PG8_SB(0, 1), cB + hstep, voffB); PG8_STAGE(PG8_SA(0, 1), cA + hstep, voffA);
        if (wr == 1) PG8_BAR;
        PG8_WAIT_V(4); PG8_BAR;
        PG8_STAGE(PG8_SB(1, 0), cB + kstep, voffB); PG8_STAGE(PG8_SA(1, 0), cA + kstep, voffA); PG8_STAGE(PG8_SB(1, 1), cB + hstep + kstep, voffB);
        PG8_WAIT_V(6); PG8_BAR;
    }
    for (;;) {
        const bool has_next = S.next(ui + 1, nxt);
        const char* nA = has_next ? (const char*)g.A + (size_t)nxt.pm * tstep : cA; const char* nB = has_next ? (const char*)g.Bt + (size_t)nxt.pn * tstep : cB;
        for (int t = 0; t < nt; t += 2) {
            const bool last = (t == nt - 2);
            const char* a1 = cA + (size_t)(t + 1) * kstep;
            const char* a2 = last ? nA : cA + (size_t)(t + 2) * kstep; const char* b2 = last ? nB : cB + (size_t)(t + 2) * kstep;
            const char* a3 = a2 + kstep; const char* b3 = b2 + kstep;
            if (last && has_next) S.a_ready(nxt);
            if constexpr (SP2) {
            PG8_LDB(B0, 0, 0); PG8_LDB(B1, 0, 1); PG8_SCHED; PG8_LDA(At, 0, 0); PG8_STAGE(PG8_SA(1, 1), a1 + hstep, voffA);
            PG8_WAIT_V(8); PG8_WAIT_L(0); PG8_BAR; PG8_MMA(0, 0, At, B0); PG8_MMA(0, 1, At, B1); PG8_BAR; PG8_SCHED;
            PG8_LDA(At, 0, 1); PG8_STAGE(PG8_SB(0, 0), b2, voffB); PG8_STAGE(PG8_SB(0, 1), b2 + hstep, voffB); PG8_STAGE(PG8_SA(0, 0), a2, voffA);
            PG8_WAIT_V(8); PG8_WAIT_L(0); PG8_BAR; PG8_MMA(1, 0, At, B0); PG8_MMA(1, 1, At, B1); PG8_BAR; PG8_SCHED;
            PG8_LDB(B0, 1, 0); PG8_LDB(B1, 1, 1); PG8_SCHED; PG8_LDA(At, 1, 0); PG8_STAGE(PG8_SA(0, 1), a2 + hstep, voffA);
            PG8_WAIT_V(8); PG8_WAIT_L(0); PG8_BAR; PG8_MMA(0, 0, At, B0); PG8_MMA(0, 1, At, B1); PG8_BAR; PG8_SCHED;
            PG8_LDA(At, 1, 1); PG8_STAGE(PG8_SB(1, 0), b3, voffB); PG8_STAGE(PG8_SB(1, 1), b3 + hstep, voffB); PG8_STAGE(PG8_SA(1, 0), a3, voffA);
            PG8_WAIT_V(8); PG8_WAIT_L(0); PG8_BAR; PG8_MMA(1, 0, At, B0); PG8_MMA(1, 1, At, B1); PG8_BAR; PG8_SCHED;
            } else {
            PG8_LDB(B0, 0, 0); PG8_SCHED; PG8_LDA(At, 0, 0); PG8_STAGE(PG8_SA(1, 1), a1 + hstep, voffA);
            PG8_WAIT_L(8); PG8_BAR; PG8_WAIT_L(0); PG8_MMA(0, 0, At, B0); PG8_BAR; PG8_SCHED;
            PG8_LDB(B1, 0, 1); PG8_STAGE(PG8_SB(0, 0), b2, voffB);
            PG8_BAR; PG8_WAIT_L(0); PG8_MMA(0, 1, At, B1); PG8_BAR;
            PG8_LDA(At, 0, 1); PG8_STAGE(PG8_SA(0, 0), a2, voffA);
            PG8_BAR; PG8_WAIT_L(0); PG8_MMA(1, 0, At, B0); PG8_BAR; PG8_SCHED;
            PG8_STAGE(PG8_SB(0, 1), b2 + hstep, voffB);
            PG8_WAIT_V(6); PG8_BAR; PG8_MMA(1, 1, At, B1); PG8_BAR;
            PG8_LDB(B0, 1, 0); PG8_SCHED; PG8_LDA(At, 1, 0); PG8_STAGE(PG8_SA(0, 1), a2 + hstep, voffA);
            PG8_WAIT_L(8); PG8_BAR; PG8_WAIT_L(0); PG8_MMA(0, 0, At, B0); PG8_BAR; PG8_SCHED;
            PG8_LDB(B1, 1, 1); PG8_STAGE(PG8_SB(1, 0), b3, voffB);
            PG8_BAR; PG8_WAIT_L(0); PG8_MMA(0, 1, At, B1); PG8_BAR;
            PG8_LDA(At, 1, 1); PG8_STAGE(PG8_SA(1, 0), a3, voffA);
            PG8_BAR; PG8_WAIT_L(0); PG8_MMA(1, 0, At, B0); PG8_BAR; PG8_SCHED;
            PG8_STAGE(PG8_SB(1, 1), b3 + hstep, voffB);
            PG8_WAIT_V(6); PG8_BAR; PG8_MMA(1, 1, At, B1); PG8_BAR;
            }
        }
        if constexpr (ALIGN_EPI) { if (wr == 0) PG8_BAR; }
        if constexpr (!Epi::AFTER_DRAIN) { E(acc, cur, wr, wc, fr, fq); S.done(cur); }
        if (!has_next) break;
#pragma unroll
        for (int a = 0; a < 2; ++a)
#pragma unroll
            for (int b = 0; b < 2; ++b)
#pragma unroll
                for (int m = 0; m < 4; ++m)
#pragma unroll
                    for (int n = 0; n < 2; ++n) acc[a][b][m][n] = (f32x4){0.f, 0.f, 0.f, 0.f};
        cur = nxt; cA = nA; cB = nB; ++ui;
        if constexpr (ALIGN_EPI) { if (wr == 1) PG8_BAR; }
    }
    PG8_WAIT_V(0);
    if constexpr (!ALIGN_EPI) { if (wr == 0) PG8_BAR; }
    PG8_BAR;
    if constexpr (Epi::AFTER_DRAIN) { E.fused(acc, cur, wr, wc, fr, fq, lds, wid, lane); S.done(cur); }
#undef PG8_SA
#undef PG8_SB
#undef PG8_STAGE
#undef PG8_LDA
#undef PG8_LDB
#undef PG8_MMA
#undef PG8_WAIT_V
#undef PG8_WAIT_L
#undef PG8_BAR
#undef PG8_SCHED
}
}
#define LAS __attribute__((address_space(3)))

#define XB_TMO      128
#define XB_XCNT(j)  (256  + 64 * (j))
#define XB_XSUB(j)  (1280 + 64 * (j))
#define XB_XGEN(j)  (2304 + 64 * (j))
#define XB_TOP      3328
#define XB_TOPGEN   3392
#define XCD_BAR_WORDS 3456
#define XB_SPIN_CAP (1u << 18)

__device__ __forceinline__ unsigned xb_ld(unsigned* p)              { return __hip_atomic_load(p, __ATOMIC_RELAXED, __HIP_MEMORY_SCOPE_AGENT); }
__device__ __forceinline__ unsigned xb_add(unsigned* p, unsigned v) { return __hip_atomic_fetch_add(p, v, __ATOMIC_RELAXED, __HIP_MEMORY_SCOPE_AGENT); }
__device__ __forceinline__ unsigned xb_xcc_id() { return (unsigned)__builtin_amdgcn_s_getreg((3 << 11) | 20) & 0xFu; }
#define XB_SPIN(cond, bar) do { unsigned _sp = 0; while (cond) { __builtin_amdgcn_s_sleep(1); \
    if ((++_sp & 255u) == 0u) { if (xb_ld(&(bar)[XB_TMO])) break; if (_sp > XB_SPIN_CAP) { atomicAdd(&(bar)[XB_TMO], 1u); break; } } } } while (0)

struct XcdBarrier {
    unsigned* bar; unsigned x;
    volatile LAS unsigned* st;
};

__device__ __forceinline__ XcdBarrier xcd_barrier_post(unsigned* bar, volatile LAS unsigned* st) {
    XcdBarrier b; b.bar = bar; b.x = xb_xcc_id(); b.st = st;
    if (threadIdx.x == 0) (void)xb_add(&bar[XB_XCNT(b.x)], 1u);
    return b;
}
__device__ __forceinline__ void xcd_barrier_complete(unsigned* bar, unsigned x, unsigned& nloc, unsigned& nx) {
    const unsigned G = gridDim.x * gridDim.y * gridDim.z;
    unsigned sum, cnt, mine, sp = 0u;
    for (;;) {
        sum = 0u; cnt = 0u; mine = 0u;
#pragma unroll
        for (unsigned j = 0; j < 16; ++j) { const unsigned c = xb_ld(&bar[XB_XCNT(j)]); sum += c; cnt += (c > 0u) ? 1u : 0u; mine = (j == x) ? c : mine; }
        if (sum == G) break;
        __builtin_amdgcn_s_sleep(1);
        if ((++sp & 255u) == 0u) { if (xb_ld(&bar[XB_TMO])) break; if (sp > XB_SPIN_CAP) { atomicAdd(&bar[XB_TMO], 1u); break; } }
    }
    nloc = mine > 0u ? mine : 1u; nx = cnt > 0u ? cnt : 1u;
}

__device__ __forceinline__ void xcd_barrier(const XcdBarrier& b) {
    asm volatile("s_waitcnt vmcnt(0)" ::: "memory");
    __syncthreads();
    if (threadIdx.x == 0) {
        unsigned* bar = b.bar;
        __builtin_amdgcn_s_waitcnt(0);
        unsigned nloc = b.st[0], nx = b.st[1];
        if (nloc == 0u) { xcd_barrier_complete(bar, b.x, nloc, nx); b.st[0] = nloc; b.st[1] = nx; }
        const unsigned old = xb_add(&bar[XB_XSUB(b.x)], 1u);
        const unsigned gen = old / nloc;
        if (old + 1u == (gen + 1u) * nloc) {
            __builtin_amdgcn_fence(__ATOMIC_RELEASE, "agent");
            asm volatile("s_waitcnt vmcnt(0)" ::: "memory");
            const unsigned og = xb_add(&bar[XB_TOP], 1u);
            const unsigned tg = og / nx;
            if (og + 1u == (tg + 1u) * nx) xb_add(&bar[XB_TOPGEN], 1u);
            else XB_SPIN(xb_ld(&bar[XB_TOPGEN]) == tg, bar);
            __builtin_amdgcn_fence(__ATOMIC_ACQUIRE, "agent");
            xb_add(&bar[XB_XGEN(b.x)], 1u);
            asm volatile("s_waitcnt vmcnt(0)" ::: "memory");
        } else {
            XB_SPIN(xb_ld(&bar[XB_XGEN(b.x)]) == gen, bar);
            __builtin_amdgcn_fence(__ATOMIC_ACQUIRE, "agent");
            asm volatile("s_waitcnt vmcnt(0)" ::: "memory");
        }
    }
    __syncthreads();
}


#define DI __device__ __forceinline__
#define LAS __attribute__((address_space(3)))
typedef unsigned short bf16_t;
typedef short bf16x8 __attribute__((ext_vector_type(8)));
typedef short s16x4 __attribute__((ext_vector_type(4)));
typedef float f32x4 __attribute__((ext_vector_type(4)));
typedef float f32x16 __attribute__((ext_vector_type(16)));
typedef unsigned u32x4 __attribute__((ext_vector_type(4)));
typedef unsigned u32x2 __attribute__((ext_vector_type(2)));
typedef LAS unsigned char* ldsp;

constexpr int D = 1024, NB = 4, SEQ = 8192, DEPTH = 4, M = NB * SEQ;
constexpr int DIN = 3344, ZLD = 3584, FF = 4096;
constexpr int C_U = 0, C_CB = 256, C_CC = 512, C_DQ = 768, C_DK = 1280, C_DV = 1792, C_GQ = 2304, C_GK = 2560, C_GV = 2816, C_GG = 3072, C_GA = 3328;
constexpr float EPS = 1e-6f;
constexpr float LOG2E = 1.4426950408889634f;

constexpr size_t LW_IN = (size_t)ZLD * D * 2, LW_OUT = (size_t)D * D * 2, LW_1 = (size_t)FF * D * 2, LW_2 = (size_t)D * FF * 2;
constexpr size_t LW = LW_IN + LW_OUT + LW_1 + LW_2;
constexpr size_t WS_WT = 0;
constexpr size_t WS_XB = WS_WT + DEPTH * LW;
constexpr size_t WS_VT = WS_XB;
constexpr size_t WS_ST = WS_XB + (size_t)32 * 1024 * 1024;
constexpr size_t WS_Z = WS_XB + (size_t)M * D * 2;
constexpr size_t WS_Y = WS_Z + (size_t)M * ZLD * 2;
constexpr size_t WS_SSQ1 = WS_Y + (size_t)M * D * 2;
constexpr size_t WS_SSQ2 = WS_SSQ1 + (size_t)M * 16 * 4;
constexpr size_t WS_DEC = WS_SSQ2 + (size_t)M * 16 * 4;
constexpr size_t WS_CTR = WS_DEC + (size_t)16 * 128 * 64 * 4;
constexpr size_t WS_BAR = WS_CTR + 16384;
constexpr size_t WS_END = WS_BAR + 16384;
static_assert(WS_Z + (size_t)M * FF * 2 <= WS_SSQ1, "h overlays z and y only");
static_assert(WS_END <= (size_t)512 * 1024 * 1024, "workspace");
constexpr int LDS_PHASE = 131072, LDS_BYTES = LDS_PHASE + 64;
DI float bflo(unsigned v) { return __uint_as_float(v << 16); }
DI float bfhi(unsigned v) { return __uint_as_float(v & 0xffff0000u); }
DI float bf1(bf16_t v) { return __uint_as_float((unsigned)v << 16); }
DI unsigned pk(float lo, float hi) { return pg8::cvt_pk_bf16(lo, hi); }
DI bf16_t f2bf(float f) { return (bf16_t)(pk(f, 0.f) & 0xffffu); }
#define LDS_WAIT() asm volatile("s_waitcnt lgkmcnt(0)" ::: "memory")

struct EpiScale {
    static constexpr bool PERM = true, AFTER_DRAIN = false;
    bf16_t* O; int ldc; const float* ssq; int act;
    DI void operator()(const f32x4 (&acc)[2][2][4][2], const pg8::Unit& u, int wr, int wc, int fr, int fq) const {
        const int row0 = u.pm * 256 + wr * 64 + fr, col0 = u.pn * 256 + wc * 32 + 8 * fq;
        f32x4 pp[8];
#pragma unroll
        for (int g = 0; g < 8; ++g) pp[g] = *(const f32x4*)(ssq + (size_t)(row0 + (g >> 2) * 128 + (g & 3) * 16) * 16 + 4 * fq);
#pragma unroll
        for (int ai = 0; ai < 2; ++ai)
#pragma unroll
            for (int m = 0; m < 4; ++m) {
                const int row = row0 + ai * 128 + m * 16;
                const f32x4 p = pp[ai * 4 + m];
                float s = (p[0] + p[1]) + (p[2] + p[3]);
                s += __shfl_xor(s, 16); s += __shfl_xor(s, 32);
                const float rstd = rsqrtf(s * (1.0f / D) + EPS);
                bf16_t* rowp = O + (size_t)row * ldc + col0;
#pragma unroll
                for (int bj = 0; bj < 2; ++bj) {
                    f32x4 v0 = acc[ai][bj][m][0] * rstd, v1 = acc[ai][bj][m][1] * rstd;
                    if (act) {
#pragma unroll
                        for (int k = 0; k < 4; ++k) { float a = fmaxf(v0[k], 0.f), b = fmaxf(v1[k], 0.f); v0[k] = a * a; v1[k] = b * b; }
                    }
                    u32x4 w; w.x = pk(v0[0], v0[1]); w.y = pk(v0[2], v0[3]); w.z = pk(v1[0], v1[1]); w.w = pk(v1[2], v1[3]);
                    *(u32x4*)(rowp + bj * 128) = w;
                }
            }
    }
};
struct EpiRes {
    static constexpr bool PERM = true, AFTER_DRAIN = false;
    const float* Xin; float* X; bf16_t* XB; float* ssq_out; float scale; int mid;
    DI void operator()(const f32x4 (&acc)[2][2][4][2], const pg8::Unit& u, int wr, int wc, int fr, int fq) const {
        const int row0 = u.pm * 256 + wr * 64 + fr, col0 = u.pn * 256 + wc * 32 + 8 * fq;
#pragma unroll
        for (int ai = 0; ai < 2; ++ai)
#pragma unroll
            for (int m = 0; m < 4; ++m) {
                const int row = row0 + ai * 128 + m * 16;
                float sq = 0.f;
#pragma unroll
                for (int bj = 0; bj < 2; ++bj) {
                    const size_t off = (size_t)row * D + col0 + bj * 128;
                    f32x4 a, b;
                    if (mid) { a = *(const f32x4*)(Xin + off); b = *(const f32x4*)(Xin + off + 4); }
                    else { const u32x4 h = *(const u32x4*)(XB + off); a = (f32x4){bflo(h.x), bfhi(h.x), bflo(h.y), bfhi(h.y)}; b = (f32x4){bflo(h.z), bfhi(h.z), bflo(h.w), bfhi(h.w)}; }
                    a += acc[ai][bj][m][0] * scale; b += acc[ai][bj][m][1] * scale;
                    if (X) { *(f32x4*)(X + off) = a; *(f32x4*)(X + off + 4) = b; }
                    sq += (a[0] * a[0] + a[1] * a[1]) + (a[2] * a[2] + a[3] * a[3]) + (b[0] * b[0] + b[1] * b[1]) + (b[2] * b[2] + b[3] * b[3]);
                    u32x4 w; w.x = pk(a[0], a[1]); w.y = pk(a[2], a[3]); w.z = pk(b[0], b[1]); w.w = pk(b[2], b[3]);
                    *(u32x4*)(XB + off) = w;
                }
                sq += __shfl_xor(sq, 16); sq += __shfl_xor(sq, 32);
                if (fq == 0) ssq_out[(size_t)row * 16 + u.pn * 4 + wc] = sq;
            }
    }
};

DI void transpose_item(const float* __restrict__ W, int K, int N, int NP, const float* __restrict__ g, bf16_t* WT, LAS float* scr, int item, int lane) {
    const int nblk = NP / 32, kb = item / nblk, nb = item % nblk, k0 = 64 * kb, n0 = 32 * nb;
    const int n = n0 + (lane & 31);
#pragma unroll
    for (int i = 0; i < 32; ++i) {
        const int kk = 2 * i + (lane >> 5);
        float v = (n < N) ? __builtin_nontemporal_load(W + (size_t)(k0 + kk) * N + n) : 0.f;
        if (g) v *= g[k0 + kk];
        scr[kk * 33 + (lane & 31)] = v;
    }
    LDS_WAIT();
    const int c = lane & 7;
#pragma unroll
    for (int j = 0; j < 4; ++j) {
        const int nn = (lane >> 3) + 8 * j; const LAS float* s = scr + (8 * c) * 33 + nn;
        u32x4 o; o.x = pk(s[0 * 33], s[1 * 33]); o.y = pk(s[2 * 33], s[3 * 33]); o.z = pk(s[4 * 33], s[5 * 33]); o.w = pk(s[6 * 33], s[7 * 33]);
        *(u32x4*)(WT + (size_t)(n0 + nn) * K + k0 + 8 * c) = o;
    }
    LDS_WAIT();
}

struct Args {
    const float* x; const float* ln1_g; const float* w_in; const float* conv_w; const float* q_norm_g; const float* k_norm_g; const float* diff_lambda;
    const float* diff_subln_g; const float* gla_alpha_w; const float* gla_alpha_b; const float* gla_norm_g; const float* w_out; const float* ln2_g;
    const float* w_mlp1; const float* w_mlp2; float* out; unsigned char* ws;
};

DI void prologue(const Args& a, ldsp lds, int tid, int G, int bid) {
    const int lane = tid & 63, wave = tid >> 6;
    LAS float* scr = (LAS float*)(lds + wave * 16384);
    const int gw = bid * 8 + wave, NGW = G * 8;
    constexpr int I_IN = (D / 64) * (ZLD / 32), I_OUT = (D / 64) * (D / 32), I_1 = (D / 64) * (FF / 32), I_2 = (FF / 64) * (D / 32);
    constexpr int I_L = I_IN + I_OUT + I_1 + I_2;
    for (int it = gw; it < DEPTH * I_L; it += NGW) {
        const int l = it / I_L; int r = it % I_L;
        bf16_t* wt = (bf16_t*)(a.ws + WS_WT + (size_t)l * LW);
        if (r < I_IN) { transpose_item(a.w_in + (size_t)l * D * DIN, D, DIN, ZLD, a.ln1_g + l * D, wt, scr, r, lane); continue; } r -= I_IN;
        wt += LW_IN / 2;
        if (r < I_OUT) { transpose_item(a.w_out + (size_t)l * D * D, D, D, D, nullptr, wt, scr, r, lane); continue; } r -= I_OUT;
        wt += LW_OUT / 2;
        if (r < I_1) { transpose_item(a.w_mlp1 + (size_t)l * D * FF, D, FF, FF, a.ln2_g + l * D, wt, scr, r, lane); continue; } r -= I_1;
        wt += LW_1 / 2;
        transpose_item(a.w_mlp2 + (size_t)l * FF * D, FF, D, D, nullptr, wt, scr, r, lane);
    }
    bf16_t* XB = (bf16_t*)(a.ws + WS_XB); float* ssq1 = (float*)(a.ws + WS_SSQ1);
    if (bid == 0 && tid < DEPTH * 16) ((unsigned*)(a.ws + WS_CTR))[tid * 64] = 0u;
    for (int m = gw; m < M; m += NGW) {
        const f32x4* xr = (const f32x4*)(a.x + (size_t)m * D) + lane;
        u32x2* xb = (u32x2*)(XB + (size_t)m * D) + lane;
        float s = 0.f;
#pragma unroll
        for (int j = 0; j < 4; ++j) {
            const f32x4 v = xr[64 * j]; s += (v[0] * v[0] + v[1] * v[1]) + (v[2] * v[2] + v[3] * v[3]);
            u32x2 o; o.x = pk(v[0], v[1]); o.y = pk(v[2], v[3]); xb[64 * j] = o;
        }
#pragma unroll
        for (int o = 1; o < 64; o <<= 1) s += __shfl_xor(s, o);
        if (lane < 16) ssq1[(size_t)m * 16 + lane] = lane == 0 ? s : 0.f;
    }
}

DI void unpack8(const u32x4 v, float (&f)[8]) {
    f[0] = bflo(v.x); f[1] = bfhi(v.x); f[2] = bflo(v.y); f[3] = bfhi(v.y); f[4] = bflo(v.z); f[5] = bfhi(v.z); f[6] = bflo(v.w); f[7] = bfhi(v.w);
}
DI u32x4 pack8(const float (&f)[8]) { u32x4 o; o.x = pk(f[0], f[1]); o.y = pk(f[2], f[3]); o.z = pk(f[4], f[5]); o.w = pk(f[6], f[7]); return o; }

DI void qk_norm(bf16_t* z, const float* qg, const float* kg, int tid, int G, int bid) {
    const int sub = tid & 127, vec = sub >> 3, l8 = sub & 7;
    const float* g = (vec < 8 ? qg : kg) + l8 * 8;
    float gv[8];
#pragma unroll
    for (int j = 0; j < 8; ++j) gv[j] = g[j] * (vec < 8 ? LOG2E * 0.125f : 1.0f);
    for (int it = bid; it < M / 32; it += G) {
        u32x4* p[8]; u32x4 v[8];
#pragma unroll
        for (int k = 0; k < 8; ++k) { p[k] = (u32x4*)(z + (size_t)(it * 32 + k * 4 + (tid >> 7)) * ZLD + C_DQ + vec * 64 + l8 * 8); v[k] = *p[k]; }
#pragma unroll
        for (int k = 0; k < 8; ++k) {
            float f[8]; unpack8(v[k], f);
            float ss = 0.f;
#pragma unroll
            for (int j = 0; j < 8; ++j) ss += f[j] * f[j];
            ss += __shfl_xor(ss, 1); ss += __shfl_xor(ss, 2); ss += __shfl_xor(ss, 4);
            const float r = rsqrtf(ss * (1.0f / 64.0f) + EPS);
#pragma unroll
            for (int j = 0; j < 8; ++j) f[j] = f[j] * r * gv[j];
            *p[k] = pack8(f);
        }
    }
}

DI void v_transpose(const bf16_t* z, bf16_t* VT, ldsp lds, int tid, int G, int bid) {
    for (int u = bid; u < 2048; u += G) {
        const int b = u >> 9, h = (u >> 7) & 3, tile = u & 127;
        __syncthreads();
#pragma unroll
        for (int i = 0; i < 2; ++i) {
            const int p = tid + 512 * i, tok = p >> 4, c16 = p & 15;
            const u32x4 v = *(const u32x4*)(z + (size_t)(b * SEQ + tile * 64 + tok) * ZLD + C_DV + h * 128 + c16 * 8);
            *(LAS u32x4*)(lds + tok * 272 + c16 * 16) = v;
        }
        __syncthreads();
        const int e = tid & 127, tg = tid >> 7, mg = tg >> 1, h2 = tg & 1;
        unsigned lo[8], hi[8];
#pragma unroll
        for (int k = 0; k < 8; ++k) {
            lo[k] = *(LAS bf16_t*)(lds + (32 * mg + 8 * h2 + k) * 272 + e * 2);
            hi[k] = *(LAS bf16_t*)(lds + (32 * mg + 16 + 8 * h2 + k) * 272 + e * 2);
        }
        u32x4* dst = (u32x4*)(VT + (size_t)((b * 4 + h) * 128 + e) * SEQ + tile * 64 + 32 * mg + 16 * h2);
        u32x4 o0, o1;
        o0.x = lo[0] | (lo[1] << 16); o0.y = lo[2] | (lo[3] << 16); o0.z = hi[0] | (hi[1] << 16); o0.w = hi[2] | (hi[3] << 16);
        o1.x = lo[4] | (lo[5] << 16); o1.y = lo[6] | (lo[7] << 16); o1.z = hi[4] | (hi[5] << 16); o1.w = hi[6] | (hi[7] << 16);
        dst[0] = o0; dst[1] = o1;
    }
}

DI void conv_phase(const bf16_t* z, bf16_t* Y, const float* cw, int tid, int G, int bid) {
    for (int idx = bid * 512 + tid; idx < M * 32; idx += G * 512) {
        const int tok = idx >> 5, cg8 = idx & 31, t = tok & (SEQ - 1);
        const bf16_t* zp = z + (size_t)tok * ZLD + cg8 * 8;
        float u0[8], c0[8], u1[8], c1[8], u2[8], c2[8], cb[8];
        unpack8(*(const u32x4*)(zp + C_U), u0); unpack8(*(const u32x4*)(zp + C_CC), c0); unpack8(*(const u32x4*)(zp + C_CB), cb);
        const bool h1 = t >= 1, h2 = t >= 2;
        const u32x4 zero = {0u, 0u, 0u, 0u};
        unpack8(h1 ? *(const u32x4*)(zp - ZLD + C_U) : zero, u1); unpack8(h1 ? *(const u32x4*)(zp - ZLD + C_CC) : zero, c1);
        unpack8(h2 ? *(const u32x4*)(zp - 2 * ZLD + C_U) : zero, u2); unpack8(h2 ? *(const u32x4*)(zp - 2 * ZLD + C_CC) : zero, c2);
        float o[8];
#pragma unroll
        for (int j = 0; j < 8; ++j) {
            const int c = cg8 * 8 + j;
            o[j] = cb[j] * (cw[2 * 256 + c] * (c0[j] * u0[j]) + cw[256 + c] * (c1[j] * u1[j]) + cw[c] * (c2[j] * u2[j]));
        }
        *(u32x4*)(Y + (size_t)tok * D + cg8 * 8) = pack8(o);
    }
}

#define MFMA16(a, b, c) __builtin_amdgcn_mfma_f32_16x16x32_bf16((a), (b), (c), 0, 0, 0)
#define MFMA32(a, b, c) __builtin_amdgcn_mfma_f32_32x32x16_bf16((a), (b), (c), 0, 0, 0)

DI void gla_scan(float* ST, const float* DEC, int tid, int G, int bid) {
    for (int u = bid; u < 128; u += G) {
        const int p = u >> 3, el = (u & 7) * 512 + tid, d = el & 63;
        float* st = ST + (size_t)p * 128 * 4096 + el; const float* dc = DEC + (size_t)p * 128 * 64 + d;
        float* so = st;
        float s = 0.f;
        for (int c0 = 0; c0 < 128; c0 += 32) {
            float kv[32], de[32];
#pragma unroll
            for (int i = 0; i < 32; ++i) { kv[i] = st[(size_t)(c0 + i) * 4096]; de[i] = dc[(c0 + i) * 64]; }
#pragma unroll
            for (int i = 0; i < 32; ++i) { so[(size_t)(c0 + i) * 4096] = s; s = de[i] * s + kv[i]; }
        }
    }
}

constexpr int G4_HEAD = 27648, G4_R1 = 9216, G4_R2 = 18432, G4_ALR = 110592, G4_TOT = 114688;
DI float log_sigmoid_fast(float x) { return fminf(x, 0.f) - __logf(1.0f + __expf(-fabsf(x))); }

template <int MODE>
DI void gla4_unit(const bf16_t* z, float* ST, float* DEC, bf16_t* Y, const float* aw_g, const float* ab_g, const float* ng, ldsp lds, int tid, int u) {
    const int b = u >> 7, c = u & 127, tok0 = b * SEQ + c * 64;
    const int hd = tid >> 7, d = tid & 63, half = (tid >> 6) & 1, lane = tid & 63, fr = lane & 15, fq = lane >> 4;
    const int p = b * 4 + hd;
    const ldsp hr = lds + hd * G4_HEAD;
    LAS float* alr = (LAS float*)(lds + G4_ALR); LAS float* tot = (LAS float*)(lds + G4_TOT);
    __syncthreads();
    {
        constexpr int NM = MODE ? 3 : 2;
#pragma unroll
        for (int i = 0; i < NM * 4; ++i) {
            const int pi = tid + 512 * i, mh = pi >> 9, mat = mh >> 2, head = mh & 3, row = (pi >> 3) & 63, pc = pi & 7;
            const int col = (MODE ? (mat == 0 ? C_GQ : (mat == 1 ? C_GK : C_GV)) : (mat == 0 ? C_GK : C_GV)) + head * 64 + pc * 8;
            const int reg = MODE ? mat * 9216 : (mat == 0 ? 0 : G4_R2);
            *(LAS u32x4*)(lds + head * G4_HEAD + reg + row * 144 + pc * 16) = *(const u32x4*)(z + (size_t)(tok0 + row) * ZLD + col);
        }
        const int idx = tid * 2, t = idx >> 4, r = idx & 15;
        const unsigned v = *(const unsigned*)(z + (size_t)(tok0 + t) * ZLD + C_GA + r);
        alr[t * 16 + r] = bflo(v); alr[t * 16 + r + 1] = bfhi(v);
    }
    float aw[16];
#pragma unroll
    for (int r = 0; r < 16; ++r) aw[r] = aw_g[r * 256 + hd * 64 + d];
    const float ab = ab_g[hd * 64 + d];
    __syncthreads();
    float bc[32];
    {
        float run = 0.f;
#pragma unroll
        for (int i = 0; i < 32; ++i) {
            const int t = 32 * half + i;
            float al = ab;
#pragma unroll
            for (int r = 0; r < 16; ++r) al += alr[t * 16 + r] * aw[r];
            run += log_sigmoid_fast(al) * (1.0f / 16.0f);
            bc[i] = run;
        }
        tot[half * 256 + hd * 64 + d] = run;
    }
    __syncthreads();
    const float t0 = tot[hd * 64 + d], t1 = tot[256 + hd * 64 + d];
    const float pre = half ? t0 : 0.f, blast = t0 + t1;
    if (MODE == 0) {
#pragma unroll
        for (int j = 0; j < 4; ++j) {
            float f[8];
#pragma unroll
            for (int k = 0; k < 8; ++k) { const int i = 8 * j + k; f[k] = bf1(*(LAS bf16_t*)(hr + (32 * half + i) * 144 + d * 2)) * __expf(blast - (bc[i] + pre)); }
            *(LAS u32x4*)(hr + G4_R1 + d * 144 + (32 * half + 8 * j) * 2) = pack8(f);
        }
        if (half == 0) DEC[(size_t)(p * 128 + c) * 64 + d] = __expf(blast);
        __syncthreads();
#pragma unroll
        for (int j = 0; j < 4; ++j) {
            unsigned w[4];
#pragma unroll
            for (int k = 0; k < 4; ++k) {
                const unsigned lo = *(LAS bf16_t*)(hr + G4_R2 + (32 * half + 8 * j + 2 * k) * 144 + d * 2), hi = *(LAS bf16_t*)(hr + G4_R2 + (32 * half + 8 * j + 2 * k + 1) * 144 + d * 2);
                w[k] = lo | (hi << 16);
            }
            u32x4 o; o.x = w[0]; o.y = w[1]; o.z = w[2]; o.w = w[3];
            *(LAS u32x4*)(hr + d * 144 + (32 * half + 8 * j) * 2) = o;
        }
        __syncthreads();
        f32x4 acc[2][4];
#pragma unroll
        for (int rt = 0; rt < 2; ++rt)
#pragma unroll
            for (int nt = 0; nt < 4; ++nt) acc[rt][nt] = (f32x4){0.f, 0.f, 0.f, 0.f};
#pragma unroll
        for (int ks = 0; ks < 2; ++ks) {
            bf16x8 af[2], bfm[4];
#pragma unroll
            for (int rt = 0; rt < 2; ++rt) af[rt] = *(LAS bf16x8*)(hr + G4_R1 + (32 * half + 16 * rt + fr) * 144 + (32 * ks + 8 * fq) * 2);
#pragma unroll
            for (int nt = 0; nt < 4; ++nt) bfm[nt] = *(LAS bf16x8*)(hr + (16 * nt + fr) * 144 + (32 * ks + 8 * fq) * 2);
#pragma unroll
            for (int rt = 0; rt < 2; ++rt)
#pragma unroll
                for (int nt = 0; nt < 4; ++nt) acc[rt][nt] = MFMA16(af[rt], bfm[nt], acc[rt][nt]);
        }
        float* st = ST + (size_t)(p * 128 + c) * 4096;
#pragma unroll
        for (int rt = 0; rt < 2; ++rt)
#pragma unroll
            for (int nt = 0; nt < 4; ++nt) *(f32x4*)(st + (16 * nt + fr) * 64 + 32 * half + 16 * rt + 4 * fq) = acc[rt][nt];
    } else {
#pragma unroll
        for (int i = 0; i < 32; ++i) {
            const float bb = bc[i] + pre;
            LAS bf16_t* qp = (LAS bf16_t*)(hr + (32 * half + i) * 144 + d * 2); LAS bf16_t* kp = (LAS bf16_t*)(hr + G4_R1 + (32 * half + i) * 144 + d * 2);
            *qp = f2bf(bf1(*qp) * 0.125f * __expf(bb)); *kp = f2bf(bf1(*kp) * __expf(-bb));
        }
        __syncthreads();
        f32x4 acc[2][4];
#pragma unroll
        for (int rt = 0; rt < 2; ++rt)
#pragma unroll
            for (int nt = 0; nt < 4; ++nt) acc[rt][nt] = (f32x4){0.f, 0.f, 0.f, 0.f};
#pragma unroll
        for (int ks = 0; ks < 2; ++ks) {
            bf16x8 af[2], bfm[4];
#pragma unroll
            for (int rt = 0; rt < 2; ++rt) af[rt] = *(LAS bf16x8*)(hr + (32 * half + 16 * rt + fr) * 144 + (32 * ks + 8 * fq) * 2);
#pragma unroll
            for (int nt = 0; nt < 4; ++nt) bfm[nt] = *(LAS bf16x8*)(hr + G4_R1 + (16 * nt + fr) * 144 + (32 * ks + 8 * fq) * 2);
#pragma unroll
            for (int rt = 0; rt < 2; ++rt)
#pragma unroll
                for (int nt = 0; nt < 4; ++nt) acc[rt][nt] = MFMA16(af[rt], bfm[nt], acc[rt][nt]);
        }
        unsigned vw[16];
#pragma unroll
        for (int k = 0; k < 16; ++k) {
            const unsigned lo = *(LAS bf16_t*)(hr + G4_R2 + (32 * half + 2 * k) * 144 + d * 2), hi = *(LAS bf16_t*)(hr + G4_R2 + (32 * half + 2 * k + 1) * 144 + d * 2);
            vw[k] = lo | (hi << 16);
        }
        __syncthreads();
#pragma unroll
        for (int rt = 0; rt < 2; ++rt)
#pragma unroll
            for (int nt = 0; nt < 4; ++nt)
#pragma unroll
                for (int r = 0; r < 4; ++r) {
                    const int t = 32 * half + 16 * rt + 4 * fq + r, sx = 16 * nt + fr;
                    *(LAS bf16_t*)(hr + G4_R1 + t * 144 + sx * 2) = f2bf(sx <= t ? acc[rt][nt][r] : 0.f);
                }
#pragma unroll
        for (int j = 0; j < 4; ++j) { u32x4 o; o.x = vw[4 * j]; o.y = vw[4 * j + 1]; o.z = vw[4 * j + 2]; o.w = vw[4 * j + 3]; *(LAS u32x4*)(hr + G4_R2 + d * 144 + (32 * half + 8 * j) * 2) = o; }
        __syncthreads();
#pragma unroll
        for (int rt = 0; rt < 2; ++rt)
#pragma unroll
            for (int nt = 0; nt < 4; ++nt) acc[rt][nt] = (f32x4){0.f, 0.f, 0.f, 0.f};
        const float* sp = ST + (size_t)(p * 128 + c) * 4096;
#pragma unroll
        for (int ks = 0; ks < 4; ++ks) {
            bf16x8 af[2], bfm[4];
            const int kk = (ks & 1) * 32 + 8 * fq;
#pragma unroll
            for (int rt = 0; rt < 2; ++rt) af[rt] = *(LAS bf16x8*)(hr + (ks < 2 ? G4_R1 : 0) + (32 * half + 16 * rt + fr) * 144 + kk * 2);
#pragma unroll
            for (int nt = 0; nt < 4; ++nt) {
                if (ks < 2) bfm[nt] = *(LAS bf16x8*)(hr + G4_R2 + (16 * nt + fr) * 144 + kk * 2);
                else { const f32x4 s0 = *(const f32x4*)(sp + (16 * nt + fr) * 64 + kk), s1 = *(const f32x4*)(sp + (16 * nt + fr) * 64 + kk + 4);
                       u32x4 o; o.x = pk(s0[0], s0[1]); o.y = pk(s0[2], s0[3]); o.z = pk(s1[0], s1[1]); o.w = pk(s1[2], s1[3]); bfm[nt] = __builtin_bit_cast(bf16x8, o); }
            }
#pragma unroll
            for (int rt = 0; rt < 2; ++rt)
#pragma unroll
                for (int nt = 0; nt < 4; ++nt) acc[rt][nt] = MFMA16(af[rt], bfm[nt], acc[rt][nt]);
        }
        __syncthreads();
#pragma unroll
        for (int rt = 0; rt < 2; ++rt)
#pragma unroll
            for (int nt = 0; nt < 4; ++nt)
#pragma unroll
                for (int r = 0; r < 4; ++r) *(LAS float*)(hr + (32 * half + 16 * rt + 4 * fq + r) * 272 + (16 * nt + fr) * 4) = acc[rt][nt][r];
        __syncthreads();
        {
            const int t7 = tid & 127, t = t7 >> 1, e0 = (t7 & 1) * 32;
            f32x4 o[8]; float ss = 0.f;
#pragma unroll
            for (int k = 0; k < 8; ++k) { o[k] = *(LAS f32x4*)(hr + t * 272 + (e0 + 4 * k) * 4); ss += (o[k][0] * o[k][0] + o[k][1] * o[k][1]) + (o[k][2] * o[k][2] + o[k][3] * o[k][3]); }
            ss += __shfl_xor(ss, 1);
            const float rs = rsqrtf(ss * (1.0f / 64.0f) + EPS);
#pragma unroll
            for (int k = 0; k < 4; ++k) {
                float gg[8]; unpack8(*(const u32x4*)(z + (size_t)(tok0 + t) * ZLD + C_GG + hd * 64 + e0 + 8 * k), gg);
                float ov[8];
#pragma unroll
                for (int j = 0; j < 8; ++j) {
                    const float x = j < 4 ? o[2 * k][j & 3] : o[2 * k + 1][j & 3];
                    ov[j] = x * rs * ng[e0 + 8 * k + j] * (gg[j] / (1.0f + __expf(-gg[j])));
                }
                *(u32x4*)(Y + (size_t)(tok0 + t) * D + 768 + hd * 64 + e0 + 8 * k) = pack8(ov);
            }
        }
    }
}

constexpr int AT_KT = 64 * 256, AT_VT = 128 * 128, AT_STG = AT_KT + AT_VT;
DI int crow16(int i) { return (i & 3) + 8 * (i >> 2); }

DI void attn_unit(const bf16_t* z, const bf16_t* VT, bf16_t* Y, const float* subg, ldsp lds, int tid, int b, int h, int qb, float lam, float ns, float oscale, int win) {
    const int w = __builtin_amdgcn_readfirstlane(tid >> 6), lane = tid & 63, fr = lane & 15, fq = lane >> 4;
    const int comp = w & 1, g = w >> 1;
    const int q0 = qb * 128 + g * 32, nt = 2 * qb + 2, wlast = 2 * qb + (g >> 1);
    const int jstart = max(0, (qb * 128 - win) >> 6), wfirst = max(0, (q0 - win) >> 6);
    bf16x8 qf[2][2];
#pragma unroll
    for (int qt = 0; qt < 2; ++qt)
#pragma unroll
        for (int ks = 0; ks < 2; ++ks) qf[qt][ks] = *(const bf16x8*)(z + (size_t)(b * SEQ + q0 + 16 * qt + fr) * ZLD + C_DQ + h * 128 + comp * 64 + 32 * ks + 8 * fq);
    f32x4 O[8][2];
#pragma unroll
    for (int e = 0; e < 8; ++e)
#pragma unroll
        for (int qt = 0; qt < 2; ++qt) O[e][qt] = (f32x4){0.f, 0.f, 0.f, 0.f};
    float ls0 = 0.f, ls1 = 0.f;
    const float tq0 = (float)(q0 + fr), tq1 = tq0 + 16.0f;
    const int kr = 4 * w + (lane >> 4), vr = 8 * w + (lane >> 3);
    const bf16_t* kg = z + (size_t)(b * SEQ + kr) * ZLD + C_DK + h * 128 + (((lane & 15) ^ (kr & 15)) * 8);
    const bf16_t* vg = VT + (size_t)((b * 4 + h) * 128 + vr) * SEQ + (((lane & 7) ^ ((vr >> 1) & 7)) * 8);
#define AT_DMA(j, buf) do { const ldsp sb = lds + (buf) * AT_STG; \
        __builtin_amdgcn_global_load_lds((const unsigned*)(kg + (size_t)(64 * (j)) * ZLD), (LAS unsigned*)(sb + w * 1024), 16, 0, 0); \
        __builtin_amdgcn_global_load_lds((const unsigned*)(kg + (size_t)(64 * (j) + 32) * ZLD), (LAS unsigned*)(sb + 8192 + w * 1024), 16, 0, 0); \
        __builtin_amdgcn_global_load_lds((const unsigned*)(vg + 64 * (j)), (LAS unsigned*)(sb + AT_KT + w * 1024), 16, 0, 0); \
        __builtin_amdgcn_global_load_lds((const unsigned*)(vg + (size_t)64 * SEQ + 64 * (j)), (LAS unsigned*)(sb + AT_KT + 8192 + w * 1024), 16, 0, 0); } while (0)
    int koff[2], voff[2];
#pragma unroll
    for (int ks = 0; ks < 2; ++ks) koff[ks] = fr * 256 + (((comp * 8 + 4 * ks + fq) ^ fr) * 16);
#pragma unroll
    for (int m = 0; m < 2; ++m) voff[m] = AT_KT + fr * 128 + (((4 * m + fq) ^ ((fr >> 1) & 7)) * 16);
    __syncthreads();
    AT_DMA(jstart, jstart & 1);
    asm volatile("s_waitcnt vmcnt(0)" ::: "memory");
    __syncthreads();
    for (int j = jstart; j < nt; ++j) {
        if (j + 1 < nt) AT_DMA(j + 1, (j + 1) & 1);
        if (j <= wlast && j >= wfirst) {
            const ldsp sb = lds + (j & 1) * AT_STG;
            f32x4 S[4][2];
#pragma unroll
            for (int kt = 0; kt < 4; ++kt)
#pragma unroll
                for (int qt = 0; qt < 2; ++qt) S[kt][qt] = (f32x4){0.f, 0.f, 0.f, 0.f};
#pragma unroll
            for (int ks = 0; ks < 2; ++ks) {
                bf16x8 kf[4];
#pragma unroll
                for (int kt = 0; kt < 4; ++kt) kf[kt] = *(LAS bf16x8*)(sb + koff[ks] + kt * 4096);
#pragma unroll
                for (int kt = 0; kt < 4; ++kt)
#pragma unroll
                    for (int qt = 0; qt < 2; ++qt) S[kt][qt] = MFMA16(kf[kt], qf[qt][ks], S[kt][qt]);
            }
            const float dl0 = (float)(64 * j + 4 * fq) - tq0, dl1 = (float)(64 * j + 4 * fq) - tq1;
#pragma unroll
            for (int m = 0; m < 2; ++m) {
                bf16x8 vf[8];
#pragma unroll
                for (int et = 0; et < 8; ++et) vf[et] = *(LAS bf16x8*)(sb + voff[m] + et * 2048);
                bf16x8 pf[2];
#pragma unroll
                for (int qt = 0; qt < 2; ++qt) {
                    const float dl = qt ? dl1 : dl0;
                    float p[8];
#pragma unroll
                    for (int i = 0; i < 8; ++i) {
                        const int kt = 2 * m + (i >> 2), r = i & 3;
                        p[i] = __builtin_amdgcn_exp2f(fmaf(fabsf(dl + (float)(16 * kt + r)), ns, S[kt][qt][r]));
                    }
                    const float sum = ((p[0] + p[1]) + (p[2] + p[3])) + ((p[4] + p[5]) + (p[6] + p[7]));
                    if (qt) ls1 += sum; else ls0 += sum;
                    u32x4 u; u.x = pk(p[0], p[1]); u.y = pk(p[2], p[3]); u.z = pk(p[4], p[5]); u.w = pk(p[6], p[7]);
                    pf[qt] = __builtin_bit_cast(bf16x8, u);
                }
#pragma unroll
                for (int et = 0; et < 8; ++et)
#pragma unroll
                    for (int qt = 0; qt < 2; ++qt) O[et][qt] = MFMA16(vf[et], pf[qt], O[et][qt]);
            }
        }
        asm volatile("s_waitcnt vmcnt(0)" ::: "memory");
        __syncthreads();
    }
#undef AT_DMA
    ls0 += __shfl_xor(ls0, 16); ls0 += __shfl_xor(ls0, 32);
    ls1 += __shfl_xor(ls1, 16); ls1 += __shfl_xor(ls1, 32);
    const float sc0 = comp ? lam / ls0 : 1.0f / ls0, sc1 = comp ? lam / ls1 : 1.0f / ls1;
    const ldsp xp = lds + g * 16384 + lane * 4;
    if (comp) {
#pragma unroll
        for (int e = 0; e < 8; ++e)
#pragma unroll
            for (int qt = 0; qt < 2; ++qt)
#pragma unroll
                for (int r = 0; r < 4; ++r) *(LAS float*)(xp + ((2 * e + qt) * 4 + r) * 256) = O[e][qt][r] * (qt ? sc1 : sc0);
    }
    __syncthreads();
    if (!comp) {
        float ss0 = 0.f, ss1 = 0.f;
#pragma unroll
        for (int e = 0; e < 8; ++e)
#pragma unroll
            for (int qt = 0; qt < 2; ++qt)
#pragma unroll
                for (int r = 0; r < 4; ++r) {
                    const float o = O[e][qt][r] * (qt ? sc1 : sc0) - *(LAS float*)(xp + ((2 * e + qt) * 4 + r) * 256);
                    O[e][qt][r] = o; if (qt) ss1 += o * o; else ss0 += o * o;
                }
        ss0 += __shfl_xor(ss0, 16); ss0 += __shfl_xor(ss0, 32);
        ss1 += __shfl_xor(ss1, 16); ss1 += __shfl_xor(ss1, 32);
        const float r0 = rsqrtf(ss0 * (1.0f / 128.0f) + EPS) * oscale, r1 = rsqrtf(ss1 * (1.0f / 128.0f) + EPS) * oscale;
#pragma unroll
        for (int qt = 0; qt < 2; ++qt) {
            bf16_t* yrow = Y + (size_t)(b * SEQ + q0 + 16 * qt + fr) * D + 256 + h * 128;
            const float rr = qt ? r1 : r0;
#pragma unroll
            for (int e = 0; e < 8; ++e) {
                const int e0 = 16 * e + 4 * fq;
                const f32x4 gn = *(const f32x4*)(subg + e0);
                u32x2 o; o.x = pk(O[e][qt][0] * rr * gn[0], O[e][qt][1] * rr * gn[1]); o.y = pk(O[e][qt][2] * rr * gn[2], O[e][qt][3] * rr * gn[3]);
                *(u32x2*)(yrow + e0) = o;
            }
        }
    }
}

__global__ void __launch_bounds__(512, 2) hybrid_fwd(Args a) {
    extern __shared__ __attribute__((aligned(16))) unsigned char lds_raw[];
    const ldsp lds = (ldsp)lds_raw;
    cg::grid_group grid = cg::this_grid();
    const int tid0 = threadIdx.x, G0 = gridDim.x, bid0 = blockIdx.x;
    unsigned char* ws = a.ws;
    bf16_t* XB = (bf16_t*)(ws + WS_XB); bf16_t* VT = (bf16_t*)a.out; float* ST = (float*)((unsigned char*)a.out + (size_t)32 * 1024 * 1024);
    bf16_t* Z = (bf16_t*)(ws + WS_Z); bf16_t* H = (bf16_t*)(ws + WS_Z); bf16_t* Y = (bf16_t*)(ws + WS_Y);
    float* SSQ1 = (float*)(ws + WS_SSQ1); float* SSQ2 = (float*)(ws + WS_SSQ2); float* DEC = (float*)(ws + WS_DEC);

    if (tid0 < 16) *(LAS unsigned*)(lds + LDS_PHASE + 4 * tid0) = 0u;
    __syncthreads();
    const XcdBarrier xbar = xcd_barrier_post((unsigned*)(ws + WS_BAR), (volatile LAS unsigned*)(lds + LDS_PHASE));
    prologue(a, lds, tid0, G0, bid0);
    grid.sync();

    for (int step = 0; step < DEPTH * 7; ++step) {
        const int l = step / 7, ph = step % 7;
        int tid = tid0; asm volatile("" : "+v"(tid));
        int G = G0, bid = bid0; asm volatile("" : "+s"(G), "+s"(bid));
        const bf16_t* wt_in = (const bf16_t*)(ws + WS_WT + (size_t)l * LW);
        const bf16_t* wt_out = wt_in + LW_IN / 2; const bf16_t* wt_1 = wt_out + LW_OUT / 2; const bf16_t* wt_2 = wt_1 + LW_1 / 2;
        if (ph == 0 || ph == 5) {
            const bool up = ph == 5;
            pg8::Gemm g{XB, up ? wt_1 : wt_in, M, up ? FF : ZLD, D}; pg8::StaticOrder S; S.init(M, up ? FF : ZLD, G, bid);
            EpiScale E{up ? H : Z, up ? FF : ZLD, up ? SSQ2 : SSQ1, up ? 1 : 0};
            pg8::gemm_phase<EpiScale, pg8::StaticOrder, true, true>(lds, g, S, E);
        } else if (ph == 4 || ph == 6) {
            const bool dn = ph == 6;
            pg8::Gemm g{dn ? H : Y, dn ? wt_2 : wt_out, M, D, dn ? FF : D}; pg8::StaticOrder S; S.init(M, D, G, bid);
            EpiRes E{a.x, (dn && l == DEPTH - 1) ? a.out : nullptr, XB, dn ? SSQ1 : SSQ2, 1.0f, (!dn && l == 0) ? 1 : 0};
            pg8::gemm_phase<EpiRes, pg8::StaticOrder, true, true>(lds, g, S, E);
        } else if (ph == 1) {
            qk_norm(Z, a.q_norm_g + l * 64, a.k_norm_g + l * 64, tid, G, bid);
            v_transpose(Z, VT, lds, tid, G, bid);
            conv_phase(Z, Y, a.conv_w + l * 3 * 256, tid, G, bid);
            for (int u = bid; u < 512; u += G) { int tu = tid; asm volatile("" : "+v"(tu)); gla4_unit<0>(Z, ST, DEC, Y, a.gla_alpha_w + (size_t)l * 16 * 256, a.gla_alpha_b + l * 256, a.gla_norm_g + l * 64, lds, tu, u); }
        } else if (ph == 2) {
            gla_scan(ST, DEC, tid, G, bid);
        } else {
            const float* lp = a.diff_lambda + l * 256;
            const int lane = tid & 63;
            float v1 = lp[lane] * lp[64 + lane], v2 = lp[128 + lane] * lp[192 + lane];
#pragma unroll
            for (int o = 1; o < 64; o <<= 1) { v1 += __shfl_xor(v1, o); v2 += __shfl_xor(v2, o); }
            const float lam_init = 0.8f - 0.6f * expf(-0.3f * (float)l);
            const float lam = expf(v1) - expf(v2) + lam_init;
            float gq = fabsf(a.q_norm_g[l * 64 + lane]), gk = fabsf(a.k_norm_g[l * 64 + lane]);
#pragma unroll
            for (int o = 1; o < 64; o <<= 1) { gq = fmaxf(gq, __shfl_xor(gq, o)); gk = fmaxf(gk, __shfl_xor(gk, o)); }
            const float smax = 8.0f * gq * gk * 1.01f;
            const int xcc = (int)(__builtin_amdgcn_s_getreg((3 << 11) | 20) & 7u);
            int it = 0;
            unsigned* ctr = (unsigned*)(ws + WS_CTR) + l * 512;
            unsigned live = 0xffu;
            for (int qi = 0; qi < 8; ++qi) {
                const int xq = (xcc + qi) & 7;
                if (qi == 1) {
                    const ldsp pm = lds + LDS_PHASE + 32;
                    if (tid < 64) {
                        const bool has = tid >= 1 && tid < 8 && __hip_atomic_load(ctr + ((xcc + tid) & 7) * 64, __ATOMIC_RELAXED, __HIP_MEMORY_SCOPE_AGENT) < 128u + 64u;
                        const unsigned long long m = __ballot(has);
                        if (tid == 0) *(LAS unsigned*)pm = (unsigned)m;
                    }
                    __syncthreads();
                    live = *(LAS unsigned*)pm;
                }
                if (!((live >> qi) & 1u)) continue;
                for (;; ++it) {
                    const ldsp slot = lds + LDS_PHASE + 16 + (it & 1) * 4;
                    if (tid == 0) *(LAS unsigned*)slot = __hip_atomic_fetch_add(ctr + xq * 64, 1u, __ATOMIC_RELAXED, __HIP_MEMORY_SCOPE_AGENT);
                    __syncthreads();
                    const int idx = (int)*(LAS unsigned*)slot;
                    if (idx >= 128 + 64) break;
                    int tu = tid; asm volatile("" : "+v"(tu));
                    if (idx < 128) {
                        const int r = 63 - (xq & 1) - 2 * (idx >> 2), h = idx & 3, b = xq >> 1;
                        const float slope = exp2f(-2.0f * (float)(h + 1));
                        const float wf = (104.0f + 2.0f * smax) / slope;
                        const int win = wf < 16384.0f ? (int)wf + 1 : 16384;
                        attn_unit(Z, VT, Y, a.diff_subln_g + l * 128, lds, tu, b, h, r, lam, -slope * LOG2E, 1.0f - lam_init, win);
                    } else {
                        gla4_unit<1>(Z, ST, DEC, Y, a.gla_alpha_w + (size_t)l * 16 * 256, a.gla_alpha_b + l * 256, a.gla_norm_g + l * 64, lds, tu, xq * 64 + idx - 128);
                    }
                }
                ++it;
            }
        }
        xcd_barrier(xbar);
    }
}

extern "C" void kernel_launch(void* const* d_in, const int* in_sizes, int n_in, void* d_out, int out_size, void* d_ws, size_t ws_size, hipStream_t stream) {
    static int grid_blocks = 0;
    if (grid_blocks == 0) {
        if (n_in != 15 || out_size != M * D || ws_size < WS_END) { fprintf(stderr, "kernel_launch: unexpected shapes (n_in %d out %d ws %zu)\n", n_in, out_size, ws_size); grid_blocks = -1; return; }
        int dev = 0, cus = 0, per_cu = 0;
        hipGetDevice(&dev);
        hipDeviceGetAttribute(&cus, hipDeviceAttributeMultiprocessorCount, dev);
        if (hipFuncSetAttribute((const void*)hybrid_fwd, hipFuncAttributeMaxDynamicSharedMemorySize, LDS_BYTES) != hipSuccess) { fprintf(stderr, "kernel_launch: hipFuncSetAttribute failed\n"); grid_blocks = -1; return; }
        if (hipOccupancyMaxActiveBlocksPerMultiprocessor(&per_cu, (const void*)hybrid_fwd, 512, LDS_BYTES) != hipSuccess || per_cu < 1) { fprintf(stderr, "kernel_launch: occupancy query gave %d\n", per_cu); per_cu = 1; }
        (void)hipGetLastError();
        grid_blocks = cus * 1;
        fprintf(stderr, "kernel_launch: cus %d per_cu %d grid %d\n", cus, per_cu, grid_blocks);
    }
    if (grid_blocks < 0) return;
    Args a{};
    a.x = (const float*)d_in[0]; a.ln1_g = (const float*)d_in[1]; a.w_in = (const float*)d_in[2]; a.conv_w = (const float*)d_in[3];
    a.q_norm_g = (const float*)d_in[4]; a.k_norm_g = (const float*)d_in[5]; a.diff_lambda = (const float*)d_in[6]; a.diff_subln_g = (const float*)d_in[7];
    a.gla_alpha_w = (const float*)d_in[8]; a.gla_alpha_b = (const float*)d_in[9]; a.gla_norm_g = (const float*)d_in[10]; a.w_out = (const float*)d_in[11];
    a.ln2_g = (const float*)d_in[12]; a.w_mlp1 = (const float*)d_in[13]; a.w_mlp2 = (const float*)d_in[14];
    a.out = (float*)d_out; a.ws = (unsigned char*)d_ws;
    if (hipMemsetAsync((char*)d_ws + WS_BAR, 0, 16384, stream) != hipSuccess) { fprintf(stderr, "kernel_launch: hipMemsetAsync failed\n"); return; }
    void* args[] = {&a};
    hipError_t e = hipLaunchCooperativeKernel((const void*)hybrid_fwd, dim3(grid_blocks), dim3(512), args, LDS_BYTES, stream);
    if (e != hipSuccess) fprintf(stderr, "kernel_launch: cooperative launch failed: %s (grid %d)\n", hipGetErrorString(e), grid_blocks);
}
```
